# Optimizing an MI355X kernel written in HIP

```python
import math
import jax, jax.numpy as jnp
from jax import lax
import numpy as np

D_MODEL = 2048
BATCH = 32
SEQ = 256
DEPTH = 1
DEC_BATCH = 4
DEC_SEQ = 1024
PAST_LEN = 512

GRID_W = 64
Q_BLOCK = 128
ROPE_THETA = 10000.0
EPS = 1e-6
H_A = 8
DK_A = 64
DV_A = 2 * DK_A
H_B = 8
KV_B = 2
DH_B = 128
G_B = H_B // KV_B
A_Q = H_A * 2 * DK_A
A_K = H_A * 2 * DK_A
A_V = H_A * DV_A
A_G = H_A * DV_A
B_Q = H_B * DH_B
B_K = KV_B * DH_B
B_V = KV_B * DH_B
B_G = H_B * DH_B
D_IN = A_Q + A_K + A_V + A_G + B_Q + B_K + B_V + B_G
D_MIX = A_V + B_Q
SPLIT_POINTS = [int(s) for s in np.cumsum([A_Q, A_K, A_V, A_G, B_Q, B_K, B_V])]

kernel_name = "hymba_diff_gqa_diffusion_step"


def rms_norm(x, g):
    xf = x.astype(jnp.float32)
    y = xf * lax.rsqrt(jnp.mean(xf * xf, axis=-1, keepdims=True) + EPS)
    return (y * g.astype(jnp.float32)).astype(x.dtype)


def adaln(cond, w_ada_l, b_ada_l):
    mod = jax.nn.silu(cond) @ w_ada_l + b_ada_l
    return jnp.split(mod, 3, axis=-1)


def axial_rope(n_tok, rot_dim):
    n_rows = n_tok // GRID_W
    rows = jnp.repeat(jnp.arange(n_rows, dtype=jnp.float32), GRID_W)
    cols = jnp.tile(jnp.arange(GRID_W, dtype=jnp.float32), n_rows)
    quarter = rot_dim // 4
    inv_freq = 1.0 / (ROPE_THETA ** (jnp.arange(quarter, dtype=jnp.float32) / quarter))
    ang = jnp.concatenate([rows[:, None] * inv_freq, cols[:, None] * inv_freq], axis=-1)
    return jnp.cos(ang), jnp.sin(ang)


def apply_rope(x, cos, sin):
    shape = (1, cos.shape[0]) + (1,) * (x.ndim - 3) + (cos.shape[1],)
    cos = cos.reshape(shape)
    sin = sin.reshape(shape)
    xf = x.astype(jnp.float32)
    x1, x2 = jnp.split(xf, 2, axis=-1)
    out = jnp.concatenate([x1 * cos - x2 * sin, x1 * sin + x2 * cos], axis=-1)
    return out.astype(x.dtype)


def sweep_query_blocks(attend, q):
    b, lq = q.shape[:2]
    nb = lq // Q_BLOCK
    qb = jnp.moveaxis(q.reshape((b, nb, Q_BLOCK) + q.shape[2:]), 1, 0)
    out = lax.map(attend, qb)
    out = jnp.moveaxis(out, 0, 1)
    return out.reshape((b, lq) + out.shape[3:])


def diff_attention(q, k, v, lam):
    scale = 1.0 / math.sqrt(DK_A)

    def attend(qb):
        s = jnp.einsum('bqhcd,bshcd->bhcqs', qb, k).astype(jnp.float32) * scale
        p = jax.nn.softmax(s, axis=-1)
        p = p[:, :, 0] - lam[None, :, None, None] * p[:, :, 1]
        return jnp.einsum('bhqs,bshe->bqhe', p.astype(v.dtype), v)

    return sweep_query_blocks(attend, q)


def gqa_attention(q, k, v):
    b, lq = q.shape[:2]
    q = q.reshape(b, lq, KV_B, G_B, DH_B)
    scale = 1.0 / math.sqrt(DH_B)

    def attend(qb):
        s = jnp.einsum('bqkgd,bskd->bkgqs', qb, k).astype(jnp.float32) * scale
        p = jax.nn.softmax(s, axis=-1)
        return jnp.einsum('bkgqs,bskd->bqkgd', p.astype(v.dtype), v)

    out = sweep_query_blocks(attend, q)
    return out.reshape(b, lq, H_B, DH_B)


def mixer_inputs(h, w_in_l, q_norm_l, k_norm_l):
    b, n = h.shape[:2]
    z = h @ w_in_l
    qa, ka, va, ga, qb, kb, vb, gb = jnp.split(z, SPLIT_POINTS, axis=-1)
    qa = qa.reshape(b, n, H_A, 2, DK_A)
    ka = ka.reshape(b, n, H_A, 2, DK_A)
    va = va.reshape(b, n, H_A, DV_A)
    qb = rms_norm(qb.reshape(b, n, H_B, DH_B), q_norm_l)
    kb = rms_norm(kb.reshape(b, n, KV_B, DH_B), k_norm_l)
    vb = vb.reshape(b, n, KV_B, DH_B)
    return qa, ka, va, ga, qb, kb, vb, gb


def mixer_outputs(oa, ob, ga, gb, subln_l, lam_init, w_out_l):
    b, n = oa.shape[:2]
    oa = rms_norm(oa, subln_l) * (1.0 - lam_init)
    o = jnp.concatenate([oa.reshape(b, n, A_V) * jax.nn.silu(ga),
                         ob.reshape(b, n, B_Q) * jax.nn.silu(gb)], axis=-1)
    return o @ w_out_l


def diff_lambda(lq1, lk1, lq2, lk2, lam_init):
    f = jnp.float32
    return (jnp.exp(jnp.sum(lq1.astype(f) * lk1.astype(f), axis=-1))
            - jnp.exp(jnp.sum(lq2.astype(f) * lk2.astype(f), axis=-1)) + lam_init)


def setup_inputs(seed: int = 0) -> dict:
    key = jax.random.key(seed)
    ks = jax.random.split(key, 24)
    f = jnp.float32
    nrm = lambda k, s: jax.random.normal(k, s, f)
    d = D_MODEL
    return {
        "x_prompt": nrm(ks[0], (BATCH, SEQ, d)),
        "x_sample": nrm(ks[1], (DEC_BATCH, DEC_SEQ, d)),
        "cache_diff_k": nrm(ks[2], (DEC_BATCH, DEPTH, PAST_LEN, H_A, 2 * DK_A)),
        "cache_diff_v": nrm(ks[3], (DEC_BATCH, DEPTH, PAST_LEN, H_A, DV_A)),
        "cache_gqa_k": nrm(ks[4], (DEC_BATCH, DEPTH, PAST_LEN, KV_B, DH_B)),
        "cache_gqa_v": nrm(ks[5], (DEC_BATCH, DEPTH, PAST_LEN, KV_B, DH_B)),
        "c": nrm(ks[6], (DEC_BATCH, d)),
        "c_ctx": nrm(ks[7], (d,)),
        "w_ada": nrm(ks[8], (DEPTH, d, 3 * d)) * (0.5 * d ** -0.5),
        "b_ada": nrm(ks[9], (DEPTH, 3 * d)) * 0.02,
        "g_norm": 1.0 + 0.05 * nrm(ks[10], (DEPTH, d)),
        "w_in": nrm(ks[11], (DEPTH, d, D_IN)) * d ** -0.5,
        "lam_q1": nrm(ks[12], (DEPTH, H_A, DK_A)) * 0.1,
        "lam_k1": nrm(ks[13], (DEPTH, H_A, DK_A)) * 0.1,
        "lam_q2": nrm(ks[14], (DEPTH, H_A, DK_A)) * 0.1,
        "lam_k2": nrm(ks[15], (DEPTH, H_A, DK_A)) * 0.1,
        "subln_g": 1.0 + 0.05 * nrm(ks[16], (DEPTH, DV_A)),
        "q_norm_g": 1.0 + 0.05 * nrm(ks[17], (DEPTH, DH_B)),
        "k_norm_g": 1.0 + 0.05 * nrm(ks[18], (DEPTH, DH_B)),
        "w_out": nrm(ks[19], (DEPTH, D_MIX, d)) * D_MIX ** -0.5,
        "g_final": 1.0 + 0.05 * nrm(ks[20], (d,)),
    }


def reference(x_prompt, x_sample, cache_diff_k, cache_diff_v, cache_gqa_k, cache_gqa_v,
              c, c_ctx, w_ada, b_ada, g_norm, w_in, lam_q1, lam_k1, lam_q2, lam_k2,
              subln_g, q_norm_g, k_norm_g, w_out, g_final):
    xp = x_prompt
    xs = x_sample
    bp, n_ctx = xp.shape[:2]
    bs, n_lat = xs.shape[:2]
    n_past = cache_diff_k.shape[2]
    cos_a, sin_a = axial_rope(n_lat, DK_A)
    cos_b, sin_b = axial_rope(n_lat, DH_B)
    st_dk, st_dv, st_gk, st_gv = [], [], [], []
    for l in range(DEPTH):
        lam_init = 0.8 - 0.6 * math.exp(-0.3 * l)
        lam = diff_lambda(lam_q1[l], lam_k1[l], lam_q2[l], lam_k2[l], lam_init)

        shift, scale, gate = adaln(c_ctx[None, None, :], w_ada[l], b_ada[l])
        h = rms_norm(xp, g_norm[l]) * (1.0 + scale) + shift
        qa, ka, va, ga, qb, kb, vb, gb = mixer_inputs(h, w_in[l], q_norm_g[l], k_norm_g[l])
        oa = diff_attention(qa, ka, va, lam)
        ob = gqa_attention(qb, kb, vb)
        xp = xp + gate * mixer_outputs(oa, ob, ga, gb, subln_g[l], lam_init, w_out[l])
        st_dk.append(ka.reshape(bp, n_ctx, H_A, 2 * DK_A))
        st_dv.append(va)
        st_gk.append(kb)
        st_gv.append(vb)

        shift, scale, gate = adaln(c[:, None, :], w_ada[l], b_ada[l])
        h = rms_norm(xs, g_norm[l]) * (1.0 + scale) + shift
        qa, ka, va, ga, qb, kb, vb, gb = mixer_inputs(h, w_in[l], q_norm_g[l], k_norm_g[l])
        qa = apply_rope(qa, cos_a, sin_a)
        ka = apply_rope(ka, cos_a, sin_a)
        qb = apply_rope(qb, cos_b, sin_b)
        kb = apply_rope(kb, cos_b, sin_b)
        ka_all = jnp.concatenate([ka, cache_diff_k[:, l].reshape(bs, n_past, H_A, 2, DK_A)], axis=1)
        va_all = jnp.concatenate([va, cache_diff_v[:, l]], axis=1)
        kb_all = jnp.concatenate([kb, cache_gqa_k[:, l]], axis=1)
        vb_all = jnp.concatenate([vb, cache_gqa_v[:, l]], axis=1)
        oa = diff_attention(qa, ka_all, va_all, lam)
        ob = gqa_attention(qb, kb_all, vb_all)
        xs = xs + gate * mixer_outputs(oa, ob, ga, gb, subln_g[l], lam_init, w_out[l])

    y_prompt = rms_norm(xp, g_final)
    y_sample = rms_norm(xs, g_final)
    new_diff_k = jnp.stack(st_dk, axis=1)
    new_diff_v = jnp.stack(st_dv, axis=1)
    new_gqa_k = jnp.stack(st_gk, axis=1)
    new_gqa_v = jnp.stack(st_gv, axis=1)
    return (y_prompt, y_sample, new_diff_k, new_diff_v, new_gqa_k, new_gqa_v)
```

```cpp
#include <hip/hip_runtime.h>
#include <hip/hip_cooperative_groups.h>
#include <cstdio>
#include <cstdint>
namespace cg = cooperative_groups;
namespace pg8 {
#define PG8_LAS __attribute__((address_space(3)))
typedef unsigned short bf16_t;
typedef short bf16x8 __attribute__((ext_vector_type(8)));
typedef float f32x4 __attribute__((ext_vector_type(4)));
typedef unsigned u32x4 __attribute__((ext_vector_type(4)));
constexpr int BM = 256, BK = 64, HALF = 128, HTB = HALF * BK * 2  , STAGE_BYTES = 8 * HTB, NXCD = 8, WGM = 8;

__host__ __device__ __forceinline__ int lds_byte(int r, int c) { const int st = (r >> 4) * 2 + (c >> 5), rr = r & 15, cc = c & 31, ob = rr * 64 + cc * 2; return st * 1024 + (ob ^ (((ob >> 9) & 1) << 5)); }
__host__ __device__ __forceinline__ void stage_rc(int b, int& R, int& C) { const int st = b / 1024, sb = b % 1024, swz = sb ^ (((sb >> 9) & 1) << 5); R = (st >> 1) * 16 + swz / 64; C = (st & 1) * 32 + (swz % 64) / 2; }
__host__ __device__ __forceinline__ int perm32(int rho) { const int n = rho >> 4, i = rho & 15; return 8 * (i >> 2) + 4 * n + (i & 3); }

struct Unit { int pm, pn; };
struct Gemm { const bf16_t* A; const bf16_t* Bt; int M, N, K; };

struct StaticOrder {
    int nM, nN, nwg, G, c;
    __host__ __device__ void init(int M, int N, int G_, int c_) { nM = M / BM; nN = N / BM; nwg = nM * nN; G = G_; c = c_; }
    __host__ __device__ bool next(int i, Unit& u) const {
        const long L = (long)i * G + c; if (L >= nwg) return false;
        int wgid = (int)L; { const int q = nwg / NXCD, r = nwg % NXCD, xcd = wgid % NXCD, off = wgid / NXCD; wgid = (xcd < r ? xcd * (q + 1) : r * (q + 1) + (xcd - r) * q) + off; }
        const int nig = WGM * nN, gid = wgid / nig, fm = gid * WGM, gsz = (nM - fm) < WGM ? (nM - fm) : WGM;
        u.pm = fm + ((wgid % nig) % gsz); u.pn = (wgid % nig) / gsz; return true;
    }
    __device__ __forceinline__ void a_ready(const Unit&) const {}
    __device__ __forceinline__ void done(const Unit&) const {}
};
struct CountedOrder : StaticOrder {
    const unsigned* ready; unsigned need; unsigned* tmo;
    __device__ __forceinline__ void a_ready(const Unit& u) const {
        if (threadIdx.x < 64) {
            const unsigned long long t0 = __builtin_amdgcn_s_memrealtime(); unsigned polls = 0;
            while ((unsigned)__builtin_amdgcn_readfirstlane(__hip_atomic_load(ready + 64 * u.pm, __ATOMIC_RELAXED, __HIP_MEMORY_SCOPE_AGENT)) < need) {
                if ((++polls & 255u) == 0u && __builtin_amdgcn_readfirstlane(__hip_atomic_load(tmo, __ATOMIC_RELAXED, __HIP_MEMORY_SCOPE_AGENT)) != 0u) break;
                if (__builtin_amdgcn_s_memrealtime() - t0 > 2000000ull) {
                    if (threadIdx.x == 0) { unsigned expect = 0u; __hip_atomic_compare_exchange_strong(tmo + 1, &expect, 0x600u | (unsigned)(u.pm & 0xff), __ATOMIC_RELAXED, __ATOMIC_RELAXED, __HIP_MEMORY_SCOPE_AGENT); __hip_atomic_store(tmo, 1u, __ATOMIC_RELAXED, __HIP_MEMORY_SCOPE_AGENT); }
                    break; }
                __builtin_amdgcn_s_sleep(2); }
            __builtin_amdgcn_fence(__ATOMIC_ACQUIRE, "agent");
            asm volatile("s_waitcnt vmcnt(0)" ::: "memory");
        }
#if !defined(BROKEN_HOOK_NO_BARRIER)
        asm volatile("" ::: "memory"); __builtin_amdgcn_s_barrier(); asm volatile("" ::: "memory");
#endif
    }
};

__device__ __forceinline__ unsigned cvt_pk_bf16(float lo, float hi) { unsigned r; asm volatile("v_cvt_pk_bf16_f32 %0, %1, %2" : "=v"(r) : "v"(lo), "v"(hi)); return r; }
typedef float f32x2 __attribute__((ext_vector_type(2)));
__device__ __forceinline__ f32x2 gelu_pk(f32x2 v) {
    const f32x2 av = __builtin_elementwise_abs(v), d = av * 0.2316418882f + 1.0f;
    f32x2 t; t.x = __builtin_amdgcn_rcpf(d.x); t.y = __builtin_amdgcn_rcpf(d.y);
    f32x2 q = t * 0.5307027145f + (-0.7265760135f); q = q * t + 0.7107068705f; q = q * t + (-0.142248368f); q = q * t + 0.127414796f; q = q * t;
    const f32x2 s = (v * v) * (-0.72134752044f);
    f32x2 e; e.x = __builtin_amdgcn_exp2f(s.x); e.y = __builtin_amdgcn_exp2f(s.y);
    const f32x2 m = v * (q * e), r = v - m;
    f32x2 o; o.x = v.x < 0.f ? m.x : r.x; o.y = v.y < 0.f ? m.y : r.y; return o;
}

template <class Epi, class Sched, bool STAMP = false>
__device__ __forceinline__ void gemm_phase(PG8_LAS unsigned char* lds, const Gemm g, const Sched& S, const Epi& E, unsigned long long* stamps) {
    int tid_o = threadIdx.x; asm volatile("" : "+v"(tid_o)); const int tid = tid_o, wid = __builtin_amdgcn_readfirstlane(tid >> 6), lane = tid & 63, wr = wid >> 2, wc = wid & 3, fr = lane & 15, fq = lane >> 4;
    const int K = g.K, nt = K / BK;
    int ts_lo = 0, ts_hi = 0, nts = 0; const unsigned long long rt_entry = STAMP ? (unsigned long long)wall_clock64() : 0ull;
#define PG8_STAMP() do { if (STAMP && wid == 0 && nts < 64) { const unsigned long long _c = (unsigned long long)clock64(); \
        ts_lo = (lane == nts) ? (int)(unsigned)_c : ts_lo; ts_hi = (lane == nts) ? (int)(unsigned)(_c >> 32) : ts_hi; ++nts; } } while (0)
    PG8_STAMP();
    unsigned voffA[2], voffB[2];
#pragma unroll
    for (int i = 0; i < 2; ++i) { int R, C; stage_rc(tid * 16 + i * 8192, R, C); const int Rb = Epi::PERM ? ((R & ~31) + perm32(R & 31)) : R;
        voffA[i] = (unsigned)(R * K + C) * 2u; voffB[i] = (unsigned)(Rb * K + C) * 2u; }
    const size_t kstep = (size_t)(BK * 2);
    const size_t hstep = (size_t)HALF * K * 2;
    const size_t tstep = 2 * hstep;
    const unsigned ldsw = (unsigned)wid * 1024u;
    const int aoff = lds_byte(wr * 64 + fr, fq * 8), boff = lds_byte(wc * 32 + fr, fq * 8);
#define PG8_SA(b, h) (((b) * 2 + (h)) * HTB)
#define PG8_SB(b, h) ((4 + (b) * 2 + (h)) * HTB)
#define PG8_STAGE(bufoff, gbase, voff) do { _Pragma("unroll") for (int _i = 0; _i < 2; ++_i) \
        __builtin_amdgcn_global_load_lds((const unsigned*)((const char*)(gbase) + (voff)[_i]), (PG8_LAS unsigned*)(lds + (bufoff) + ldsw + _i * 8192), 16, 0, 0); } while (0)
#define PG8_LDA(dst, b, h) do { _Pragma("unroll") for (int m = 0; m < 4; ++m) _Pragma("unroll") for (int k = 0; k < 2; ++k) dst[m][k] = *(const PG8_LAS bf16x8*)(lds + PG8_SA(b, h) + aoff + m * 2048 + k * 1024); } while (0)
#define PG8_LDB(dst, b, h) do { _Pragma("unroll") for (int n = 0; n < 2; ++n) _Pragma("unroll") for (int k = 0; k < 2; ++k) dst[n][k] = *(const PG8_LAS bf16x8*)(lds + PG8_SB(b, h) + boff + n * 2048 + k * 1024); } while (0)
#define PG8_MMA(ai, bj, At, Bt) do { __builtin_amdgcn_s_setprio(1); _Pragma("unroll") for (int m = 0; m < 4; ++m) _Pragma("unroll") for (int n = 0; n < 2; ++n) _Pragma("unroll") for (int k = 0; k < 2; ++k) \
        acc[ai][bj][m][n] = __builtin_amdgcn_mfma_f32_16x16x32_bf16(Bt[n][k], At[m][k], acc[ai][bj][m][n], 0, 0, 0); __builtin_amdgcn_s_setprio(0); } while (0)
#define PG8_WAIT_V(n) asm volatile("s_waitcnt vmcnt(" #n ")" ::: "memory")
#define PG8_WAIT_L(n) asm volatile("s_waitcnt lgkmcnt(" #n ")" ::: "memory")
#define PG8_BAR __builtin_amdgcn_s_barrier()
#define PG8_SCHED __builtin_amdgcn_sched_barrier(0)
    Unit cur, nxt; int ui = 0;
    if (!S.next(0, cur)) return;
    f32x4 acc[2][2][4][2];
#pragma unroll
    for (int a = 0; a < 2; ++a)
#pragma unroll
        for (int b = 0; b < 2; ++b)
#pragma unroll
            for (int m = 0; m < 4; ++m)
#pragma unroll
                for (int n = 0; n < 2; ++n) acc[a][b][m][n] = (f32x4){0.f, 0.f, 0.f, 0.f};
    bf16x8 At[4][2], B0[2][2], B1[2][2];
    const char* cA = (const char*)g.A + (size_t)cur.pm * tstep; const char* cB = (const char*)g.Bt + (size_t)cur.pn * tstep;
    S.a_ready(cur);
    PG8_STAGE(PG8_SB(0, 0), cB, voffB); PG8_STAGE(PG8_SA(0, 0), cA, voffA); PG8_STAGE(PG8_SB(0, 1), cB + hstep, voffB); PG8_STAGE(PG8_SA(0, 1), cA + hstep, voffA);
    if (wr == 1) PG8_BAR;
    PG8_WAIT_V(4); PG8_BAR;
    PG8_STAGE(PG8_SB(1, 0), cB + kstep, voffB); PG8_STAGE(PG8_SA(1, 0), cA + kstep, voffA); PG8_STAGE(PG8_SB(1, 1), cB + hstep + kstep, voffB);
    PG8_WAIT_V(6); PG8_BAR;
    PG8_STAMP();
    for (;;) {
        const bool has_next = S.next(ui + 1, nxt);
        const char* nA = has_next ? (const char*)g.A + (size_t)nxt.pm * tstep : cA; const char* nB = has_next ? (const char*)g.Bt + (size_t)nxt.pn * tstep : cB;
        for (int t = 0; t < nt; t += 2) {
            const bool last = (t == nt - 2);
            const char* a1 = cA + (size_t)(t + 1) * kstep;
            const char* a2 = last ? nA : cA + (size_t)(t + 2) * kstep; const char* b2 = last ? nB : cB + (size_t)(t + 2) * kstep;
            const char* a3 = a2 + kstep; const char* b3 = b2 + kstep;
            if (last && has_next) S.a_ready(nxt);
            PG8_LDB(B0, 0, 0); PG8_SCHED; PG8_LDA(At, 0, 0); PG8_STAGE(PG8_SA(1, 1), a1 + hstep, voffA);
            PG8_WAIT_L(8); PG8_BAR; PG8_WAIT_L(0); PG8_MMA(0, 0, At, B0); PG8_BAR; PG8_SCHED;
            PG8_LDB(B1, 0, 1); PG8_STAGE(PG8_SB(0, 0), b2, voffB);
            PG8_BAR; PG8_WAIT_L(0); PG8_MMA(0, 1, At, B1); PG8_BAR;
            PG8_LDA(At, 0, 1); PG8_STAGE(PG8_SA(0, 0), a2, voffA);
            PG8_BAR; PG8_WAIT_L(0); PG8_MMA(1, 0, At, B0); PG8_BAR; PG8_SCHED;
            PG8_STAGE(PG8_SB(0, 1), b2 + hstep, voffB);
            PG8_WAIT_V(6); PG8_BAR; PG8_MMA(1, 1, At, B1); PG8_BAR;
            PG8_LDB(B0, 1, 0); PG8_SCHED; PG8_LDA(At, 1, 0); PG8_STAGE(PG8_SA(0, 1), a2 + hstep, voffA);
            PG8_WAIT_L(8); PG8_BAR; PG8_WAIT_L(0); PG8_MMA(0, 0, At, B0); PG8_BAR; PG8_SCHED;
            PG8_LDB(B1, 1, 1); PG8_STAGE(PG8_SB(1, 0), b3, voffB);
            PG8_BAR; PG8_WAIT_L(0); PG8_MMA(0, 1, At, B1); PG8_BAR;
            PG8_LDA(At, 1, 1); PG8_STAGE(PG8_SA(1, 0), a3, voffA);
            PG8_BAR; PG8_WAIT_L(0); PG8_MMA(1, 0, At, B0); PG8_BAR; PG8_SCHED;
            PG8_STAGE(PG8_SB(1, 1), b3 + hstep, voffB);
            PG8_WAIT_V(6); PG8_BAR; PG8_MMA(1, 1, At, B1); PG8_BAR;
        }
        PG8_STAMP();
        if constexpr (!Epi::AFTER_DRAIN) { E(acc, cur, wr, wc, fr, fq); S.done(cur); }
        PG8_STAMP();
        if (!has_next) break;
#pragma unroll
        for (int a = 0; a < 2; ++a)
#pragma unroll
            for (int b = 0; b < 2; ++b)
#pragma unroll
                for (int m = 0; m < 4; ++m)
#pragma unroll
                    for (int n = 0; n < 2; ++n) acc[a][b][m][n] = (f32x4){0.f, 0.f, 0.f, 0.f};
        cur = nxt; cA = nA; cB = nB; ++ui;
    }
    PG8_WAIT_V(0);
    if (wr == 0) PG8_BAR;
    PG8_BAR;
    if constexpr (Epi::AFTER_DRAIN) { E.fused(acc, cur, wr, wc, fr, fq, lds, wid, lane); S.done(cur); }
    PG8_STAMP();
    if (STAMP && wid == 0) { stamps[lane] = lane < nts ? (((unsigned long long)(unsigned)ts_hi << 32) | (unsigned)ts_lo) : 0ull;
        if (lane == 62) stamps[62] = rt_entry; if (lane == 63) stamps[63] = (unsigned long long)wall_clock64(); }
#undef PG8_STAMP
#undef PG8_SA
#undef PG8_SB
#undef PG8_STAGE
#undef PG8_LDA
#undef PG8_LDB
#undef PG8_MMA
#undef PG8_WAIT_V
#undef PG8_WAIT_L
#undef PG8_BAR
#undef PG8_SCHED
}
}

typedef unsigned short bf16_t;
constexpr int DM = 2048, NCTX = 8192, NLAT = 4096, MTOK = 12288, DIN = 6656, LKV = 1536;
constexpr int ZQA = 0, ZKA = 1024, ZVA = 2048, ZGA = 3072, ZQB = 4096, ZKB = 5120, ZVB = 5376, ZGB = 5632;
constexpr float EPS = 1e-6f;
constexpr size_t MiB = 1048576;
constexpr size_t WS_MOD = 0, WS_CTR = 512 * 1024, WS_WOUT = 1 * MiB, WS_KA = 9 * MiB, WS_VA = 21 * MiB, WS_KB = 33 * MiB, WS_VB = 36 * MiB,
                 WS_Z = 40 * MiB, WS_O = 196 * MiB, WS_WIN = WS_O, WS_END = 244 * MiB;
constexpr size_t OUT_Y = 0, OUT_NDK = (size_t)MTOK * DM, OUT_NDV = OUT_NDK + (size_t)NCTX * 1024, OUT_NGK = OUT_NDV + (size_t)NCTX * 1024, OUT_NGV = OUT_NGK + (size_t)NCTX * 256;
constexpr int LDS_BYTES = 132 * 1024;

struct Params {
    const float *x_prompt, *x_sample, *cdk, *cdv, *cgk, *cgv, *c, *c_ctx, *w_ada, *b_ada, *g_norm, *w_in, *lq1, *lk1, *lq2, *lk2, *subln, *qng, *kng, *w_out, *g_final;
    float* out; unsigned char* ws;
};

typedef short bf16x8 __attribute__((ext_vector_type(8)));
typedef short s16x4 __attribute__((ext_vector_type(4)));
typedef float f32x4 __attribute__((ext_vector_type(4)));
typedef float f32x16 __attribute__((ext_vector_type(16)));
typedef unsigned u32x4 __attribute__((ext_vector_type(4)));
typedef unsigned u32x2 __attribute__((ext_vector_type(2)));

__device__ __forceinline__ unsigned cvtpk(float lo, float hi) { unsigned r; asm volatile("v_cvt_pk_bf16_f32 %0, %1, %2" : "=v"(r) : "v"(lo), "v"(hi)); return r; }
__device__ __forceinline__ float bf_lo(unsigned w) { return __uint_as_float(w << 16); }
__device__ __forceinline__ float bf_hi(unsigned w) { return __uint_as_float(w & 0xffff0000u); }
__device__ __forceinline__ float bf2f(bf16_t b) { return __uint_as_float(((unsigned)b) << 16); }
__device__ __forceinline__ bf16_t f2bf(float f) { unsigned u = __float_as_uint(f); u += 0x7fffu + ((u >> 16) & 1u); return (bf16_t)(u >> 16); }
__device__ __forceinline__ float wave_sum(float v) {
    v += __shfl_xor(v, 32); v += __shfl_xor(v, 16); v += __shfl_xor(v, 8); v += __shfl_xor(v, 4); v += __shfl_xor(v, 2); v += __shfl_xor(v, 1); return v;
}
__device__ __forceinline__ float silu_f(float v) { return v / (1.0f + __expf(-v)); }
__device__ __forceinline__ void sincos_rev(float a, float& s, float& c) { float r = a * 0.15915494309189535f; r = r - floorf(r); s = __builtin_amdgcn_sinf(r); c = __builtin_amdgcn_cosf(r); }

struct EpiZ {
    static constexpr bool PERM = true, AFTER_DRAIN = false;
    bf16_t* O;
    __device__ __forceinline__ void operator()(const pg8::f32x4 (&acc)[2][2][4][2], const pg8::Unit& u, int wr, int wc, int fr, int fq) const {
        const int row0 = u.pm * 256 + wr * 64 + fr; const int col0 = u.pn * 256 + wc * 32 + 8 * fq;
#pragma unroll
        for (int ai = 0; ai < 2; ++ai)
#pragma unroll
            for (int m = 0; m < 4; ++m) { bf16_t* rowp = O + (size_t)(row0 + ai * 128 + m * 16) * DIN + col0;
#pragma unroll
                for (int bj = 0; bj < 2; ++bj) { const pg8::f32x4 v0 = acc[ai][bj][m][0], v1 = acc[ai][bj][m][1];
                    u32x4 w; w.x = cvtpk(v0[0], v0[1]); w.y = cvtpk(v0[2], v0[3]); w.z = cvtpk(v1[0], v1[1]); w.w = cvtpk(v1[2], v1[3]);
                    *(u32x4*)(rowp + bj * 128) = w; } }
    }
};
struct EpiRes {
    static constexpr bool PERM = false, AFTER_DRAIN = false;
    const float* xp; const float* xs; const float* mod; float* out;
    __device__ __forceinline__ void operator()(const pg8::f32x4 (&acc)[2][2][4][2], const pg8::Unit& u, int wr, int wc, int fr, int fq) const {
        const int row0 = u.pm * 256 + wr * 64 + fr; const int col0 = u.pn * 256 + wc * 32 + 4 * fq;
        const int cnd = u.pm < 32 ? 0 : 1 + ((u.pm - 32) >> 2);
        const float* gate = mod + cnd * 6144 + 4096 + col0;
        pg8::f32x4 gv[2][2];
#pragma unroll
        for (int bj = 0; bj < 2; ++bj)
#pragma unroll
            for (int n = 0; n < 2; ++n) gv[bj][n] = *(const pg8::f32x4*)(gate + bj * 128 + n * 16);
#pragma unroll
        for (int ai = 0; ai < 2; ++ai)
#pragma unroll
            for (int m = 0; m < 4; ++m) { const int row = row0 + ai * 128 + m * 16;
                const float* xr = (row < NCTX ? xp + (size_t)row * DM : xs + (size_t)(row - NCTX) * DM) + col0;
                float* orow = out + (size_t)row * DM + col0;
#pragma unroll
                for (int bj = 0; bj < 2; ++bj)
#pragma unroll
                    for (int n = 0; n < 2; ++n) { const pg8::f32x4 xv = *(const pg8::f32x4*)(xr + bj * 128 + n * 16);
                        *(pg8::f32x4*)(orow + bj * 128 + n * 16) = xv + gv[bj][n] * acc[ai][bj][m][n]; } }
    }
};

__device__ __forceinline__ void phase0(const Params& p, unsigned char* lds) {
    int tid_o = threadIdx.x; asm volatile("" : "+v"(tid_o)); const int tid = tid_o, wid = tid >> 6, lane = tid & 63, G = gridDim.x, bid = blockIdx.x;
    if (bid == 0 && tid == 0) *(unsigned*)(p.ws + WS_CTR) = 0u;
    float* mod = (float*)(p.ws + WS_MOD);
    for (int item = bid; item < 192; item += G) {
        float* sil = (float*)lds;
        float* red = (float*)(lds + 40960);
        for (int i = tid; i < 5 * 2048; i += 512) { const int cn = i >> 11, k = i & 2047; const float v = cn == 0 ? p.c_ctx[k] : p.c[(cn - 1) * 2048 + k]; sil[i] = silu_f(v); }
        __syncthreads();
        const int col0 = item * 32 + (lane & 7) * 4, rsub = lane >> 3;
        float a0[4] = {0.f, 0.f, 0.f, 0.f}, a1[4] = {0.f, 0.f, 0.f, 0.f}, a2[4] = {0.f, 0.f, 0.f, 0.f}, a3[4] = {0.f, 0.f, 0.f, 0.f}, a4[4] = {0.f, 0.f, 0.f, 0.f};
        const float* wp = p.w_ada + (size_t)(wid * 256 + rsub) * 6144 + col0;
#pragma unroll 8
        for (int it = 0; it < 32; ++it) {
            const f32x4 w = *(const f32x4*)(wp + (size_t)it * 8 * 6144);
            const int k = wid * 256 + it * 8 + rsub;
            const float s0 = sil[k], s1 = sil[2048 + k], s2 = sil[4096 + k], s3 = sil[6144 + k], s4 = sil[8192 + k];
#pragma unroll
            for (int j = 0; j < 4; ++j) { a0[j] += s0 * w[j]; a1[j] += s1 * w[j]; a2[j] += s2 * w[j]; a3[j] += s3 * w[j]; a4[j] += s4 * w[j]; }
        }
#pragma unroll
        for (int j = 0; j < 4; ++j) {
            a0[j] += __shfl_xor(a0[j], 8); a0[j] += __shfl_xor(a0[j], 16); a0[j] += __shfl_xor(a0[j], 32);
            a1[j] += __shfl_xor(a1[j], 8); a1[j] += __shfl_xor(a1[j], 16); a1[j] += __shfl_xor(a1[j], 32);
            a2[j] += __shfl_xor(a2[j], 8); a2[j] += __shfl_xor(a2[j], 16); a2[j] += __shfl_xor(a2[j], 32);
            a3[j] += __shfl_xor(a3[j], 8); a3[j] += __shfl_xor(a3[j], 16); a3[j] += __shfl_xor(a3[j], 32);
            a4[j] += __shfl_xor(a4[j], 8); a4[j] += __shfl_xor(a4[j], 16); a4[j] += __shfl_xor(a4[j], 32);
        }
        if (lane < 8) {
#pragma unroll
            for (int j = 0; j < 4; ++j) { red[(wid * 5 + 0) * 32 + lane * 4 + j] = a0[j]; red[(wid * 5 + 1) * 32 + lane * 4 + j] = a1[j]; red[(wid * 5 + 2) * 32 + lane * 4 + j] = a2[j];
                red[(wid * 5 + 3) * 32 + lane * 4 + j] = a3[j]; red[(wid * 5 + 4) * 32 + lane * 4 + j] = a4[j]; }
        }
        __syncthreads();
        if (tid < 160) { const int cn = tid >> 5, col = tid & 31; float s = 0.f;
#pragma unroll
            for (int w = 0; w < 8; ++w) s += red[(w * 5 + cn) * 32 + col];
            const int gc = item * 32 + col; mod[cn * 6144 + gc] = s + p.b_ada[gc]; }
        __syncthreads();
    }
    {
        float* tl = (float*)(lds + 49152);
        constexpr int NT_IN = 32 * 104, NT_ALL = NT_IN + 32 * 32;
        for (int t = bid; t < NT_ALL; t += G) {
            const float* src; bf16_t* dst; int N, kt, ntl;
            if (t < NT_IN) { src = p.w_in; dst = (bf16_t*)(p.ws + WS_WIN); N = DIN; kt = t / 104; ntl = t - kt * 104; }
            else { const int t2 = t - NT_IN; src = p.w_out; dst = (bf16_t*)(p.ws + WS_WOUT); N = DM; kt = t2 >> 5; ntl = t2 & 31; }
            const int rk = tid >> 4, c4 = (tid & 15) * 4;
#pragma unroll
            for (int ps = 0; ps < 2; ++ps) { const int k = rk + ps * 32; const f32x4 v = *(const f32x4*)(src + (size_t)(kt * 64 + k) * N + ntl * 64 + c4);
                tl[k * 65 + c4 + 0] = v[0]; tl[k * 65 + c4 + 1] = v[1]; tl[k * 65 + c4 + 2] = v[2]; tl[k * 65 + c4 + 3] = v[3]; }
            __syncthreads();
            const int n = tid >> 3, k8 = (tid & 7) * 8;
            u32x4 w; w.x = cvtpk(tl[(k8 + 0) * 65 + n], tl[(k8 + 1) * 65 + n]); w.y = cvtpk(tl[(k8 + 2) * 65 + n], tl[(k8 + 3) * 65 + n]);
            w.z = cvtpk(tl[(k8 + 4) * 65 + n], tl[(k8 + 5) * 65 + n]); w.w = cvtpk(tl[(k8 + 6) * 65 + n], tl[(k8 + 7) * 65 + n]);
            *(u32x4*)(dst + (size_t)(ntl * 64 + n) * 2048 + kt * 64 + k8) = w;
            __syncthreads();
        }
    }
    {
        constexpr int C1 = 262144, C2 = 524288, C3 = 589824, C4 = 655360;
        for (int i = bid * 512 + tid; i < C4; i += G * 512) {
            const float* src; bf16_t* dst; int j, Wd;
            if (i < C1) { src = p.cdk; dst = (bf16_t*)(p.ws + WS_KA); j = i; Wd = 1024; }
            else if (i < C2) { src = p.cdv; dst = (bf16_t*)(p.ws + WS_VA); j = i - C1; Wd = 1024; }
            else if (i < C3) { src = p.cgk; dst = (bf16_t*)(p.ws + WS_KB); j = i - C2; Wd = 256; }
            else { src = p.cgv; dst = (bf16_t*)(p.ws + WS_VB); j = i - C3; Wd = 256; }
            const int e = j * 8; const int per_b = 512 * Wd; const int b = e / per_b, rem = e - b * per_b, s = rem / Wd, col = rem - s * Wd;
            const f32x4 v0 = *(const f32x4*)(src + e), v1 = *(const f32x4*)(src + e + 4);
            u32x4 w; w.x = cvtpk(v0[0], v0[1]); w.y = cvtpk(v0[2], v0[3]); w.z = cvtpk(v1[0], v1[1]); w.w = cvtpk(v1[2], v1[3]);
            *(u32x4*)(dst + ((size_t)(b * LKV + 1024 + s)) * Wd + col) = w;
        }
    }
}

__device__ __forceinline__ void phase1(const Params& p) {
    int tid_o = threadIdx.x; asm volatile("" : "+v"(tid_o)); const int tid = tid_o, wid = tid >> 6, lane = tid & 63, G = gridDim.x, bid = blockIdx.x;
    const float* mod = (const float*)(p.ws + WS_MOD);
    bf16_t* h = (bf16_t*)p.out;
    for (int row = bid * 8 + wid; row < MTOK; row += G * 8) {
        const float* xr = row < NCTX ? p.x_prompt + (size_t)row * DM : p.x_sample + (size_t)(row - NCTX) * DM;
        const int cn = row < NCTX ? 0 : 1 + ((row - NCTX) >> 10);
        f32x4 v[8]; float ss = 0.f;
#pragma unroll
        for (int i = 0; i < 8; ++i) { v[i] = *(const f32x4*)(xr + i * 256 + lane * 4); ss += v[i][0] * v[i][0] + v[i][1] * v[i][1] + v[i][2] * v[i][2] + v[i][3] * v[i][3]; }
        ss = wave_sum(ss);
        const float rstd = rsqrtf(ss * (1.0f / DM) + EPS);
        const float* sh = mod + cn * 6144; const float* sc = sh + 2048;
#pragma unroll
        for (int i = 0; i < 8; ++i) { const int col = i * 256 + lane * 4;
            const f32x4 g = *(const f32x4*)(p.g_norm + col), s1 = *(const f32x4*)(sc + col), s0 = *(const f32x4*)(sh + col);
            const f32x4 y = (v[i] * rstd) * g * (s1 + 1.0f) + s0;
            u32x2 w; w.x = cvtpk(y[0], y[1]); w.y = cvtpk(y[2], y[3]);
            *(u32x2*)(h + (size_t)row * DM + col) = w; }
    }
}

__device__ __forceinline__ void phase2b(const Params& p) {
    int tid_o = threadIdx.x; asm volatile("" : "+v"(tid_o)); const int tid = tid_o, wid = tid >> 6, lane = tid & 63, G = gridDim.x, bid = blockIdx.x;
    bf16_t* z = (bf16_t*)(p.ws + WS_Z);
    const float qg0 = p.qng[lane * 2], qg1 = p.qng[lane * 2 + 1], kg0 = p.kng[lane * 2], kg1 = p.kng[lane * 2 + 1];
    const float L2T = 13.287712379549449f;
    for (int row = bid * 8 + wid; row < MTOK; row += G * 8) {
        bf16_t* zr = z + (size_t)row * DIN;
        if (row < NCTX) {
#pragma unroll
            for (int i = 0; i < 2; ++i) { const int col = i * 512 + lane * 8;
                const u32x4 a = *(const u32x4*)(zr + ZKA + col); float* o = p.out + OUT_NDK + (size_t)row * 1024 + col;
                *(f32x4*)o = (f32x4){bf_lo(a.x), bf_hi(a.x), bf_lo(a.y), bf_hi(a.y)}; *(f32x4*)(o + 4) = (f32x4){bf_lo(a.z), bf_hi(a.z), bf_lo(a.w), bf_hi(a.w)};
                const u32x4 b = *(const u32x4*)(zr + ZVA + col); float* o2 = p.out + OUT_NDV + (size_t)row * 1024 + col;
                *(f32x4*)o2 = (f32x4){bf_lo(b.x), bf_hi(b.x), bf_lo(b.y), bf_hi(b.y)}; *(f32x4*)(o2 + 4) = (f32x4){bf_lo(b.z), bf_hi(b.z), bf_lo(b.w), bf_hi(b.w)}; }
            { const u32x2 a = *(const u32x2*)(zr + ZVB + lane * 4);
              *(f32x4*)(p.out + OUT_NGV + (size_t)row * 256 + lane * 4) = (f32x4){bf_lo(a.x), bf_hi(a.x), bf_lo(a.y), bf_hi(a.y)}; }
#pragma unroll
            for (int hd = 0; hd < 10; ++hd) { const int base = hd < 8 ? ZQB + hd * 128 : ZKB + (hd - 8) * 128;
                const unsigned w = *(const unsigned*)(zr + base + lane * 2); float a = bf_lo(w), b = bf_hi(w);
                const float ss = wave_sum(a * a + b * b); const float r = rsqrtf(ss * (1.0f / 128.0f) + EPS);
                a = a * r * (hd < 8 ? qg0 : kg0); b = b * r * (hd < 8 ? qg1 : kg1);
                *(unsigned*)(zr + base + lane * 2) = cvtpk(a, b);
                if (hd >= 8) { float* o = p.out + OUT_NGK + (size_t)row * 256 + (hd - 8) * 128 + lane * 2; o[0] = a; o[1] = b; } }
        } else {
            const int lr = row - NCTX, b = lr >> 10, pos = lr & 1023; const float prow = (float)(pos >> 6), pcol = (float)(pos & 63);
            const size_t krow = (size_t)(b * LKV + pos);
            float cA0, sA0, cA1, sA1; const bool firstA = (lane & 16) == 0;
            { const int f = (lane * 2) & 31;
              const float a0 = (f < 16 ? prow : pcol) * exp2f(-(float)(f & 15) * (L2T / 16.0f)), a1 = ((f + 1) < 16 ? prow : pcol) * exp2f(-(float)((f + 1) & 15) * (L2T / 16.0f));
              sincos_rev(a0, sA0, cA0); sincos_rev(a1, sA1, cA1); }
#pragma unroll 4
            for (int ch = 0; ch < 16; ++ch) { const int base = (ch < 8 ? ZQA : ZKA) + (ch & 7) * 128;
                const unsigned w = *(const unsigned*)(zr + base + lane * 2); const float a = bf_lo(w), bb = bf_hi(w);
                const float pa = __shfl_xor(a, 16), pb = __shfl_xor(bb, 16);
                const float o0 = firstA ? a * cA0 - pa * sA0 : pa * sA0 + a * cA0, o1 = firstA ? bb * cA1 - pb * sA1 : pb * sA1 + bb * cA1;
                if (ch < 8) *(unsigned*)(zr + base + lane * 2) = cvtpk(o0, o1);
                else *(unsigned*)((bf16_t*)(p.ws + WS_KA) + krow * 1024 + (ch & 7) * 128 + lane * 2) = cvtpk(o0, o1); }
#pragma unroll
            for (int i = 0; i < 2; ++i) { const int col = i * 512 + lane * 8; *(u32x4*)((bf16_t*)(p.ws + WS_VA) + krow * 1024 + col) = *(const u32x4*)(zr + ZVA + col); }
            *(u32x2*)((bf16_t*)(p.ws + WS_VB) + krow * 256 + lane * 4) = *(const u32x2*)(zr + ZVB + lane * 4);
            float cB0, sB0, cB1, sB1; const bool firstB = lane < 32;
            { const int f = (lane * 2) & 63;
              const float a0 = (f < 32 ? prow : pcol) * exp2f(-(float)(f & 31) * (L2T / 32.0f)), a1 = ((f + 1) < 32 ? prow : pcol) * exp2f(-(float)((f + 1) & 31) * (L2T / 32.0f));
              sincos_rev(a0, sB0, cB0); sincos_rev(a1, sB1, cB1); }
#pragma unroll 2
            for (int hd = 0; hd < 10; ++hd) { const int base = hd < 8 ? ZQB + hd * 128 : ZKB + (hd - 8) * 128;
                const unsigned w = *(const unsigned*)(zr + base + lane * 2); float a = bf_lo(w), bb = bf_hi(w);
                const float ss = wave_sum(a * a + bb * bb); const float r = rsqrtf(ss * (1.0f / 128.0f) + EPS);
                a = a * r * (hd < 8 ? qg0 : kg0); bb = bb * r * (hd < 8 ? qg1 : kg1);
                const float pa = __shfl_xor(a, 32), pb = __shfl_xor(bb, 32);
                const float o0 = firstB ? a * cB0 - pa * sB0 : pa * sB0 + a * cB0, o1 = firstB ? bb * cB1 - pb * sB1 : pb * sB1 + bb * cB1;
                if (hd < 8) *(unsigned*)(zr + base + lane * 2) = cvtpk(o0, o1);
                else *(unsigned*)((bf16_t*)(p.ws + WS_KB) + krow * 256 + (hd - 8) * 128 + lane * 2) = cvtpk(o0, o1); }
        }
    }
}

namespace at {
constexpr int NW = 8, QBLK = 32, KVBLK = 64;
constexpr float THR = 8.f;
constexpr int SHM_V = 16384, SHM_K = 16384;
#define AT_SBAR() __builtin_amdgcn_sched_barrier(0)
template <int DK> __device__ __forceinline__ int kswz(int row, int colB) { return DK == 128 ? row * 256 + (colB ^ ((row & 7) << 4)) : row * 128 + (colB ^ (((row >> 1) & 7) << 4)); }
__device__ __forceinline__ int crow(int r, int hi) { return (r & 3) + 8 * (r >> 2) + 4 * hi; }

template <int DK> __device__ __forceinline__ void partialSM(f32x16& p0, f32x16& p1, float& m_reg, float& mn, float& alpha) {
    constexpr float SCALE = DK == 128 ? 0.088388347648318440f : 0.125f;
    constexpr float C = SCALE * 1.4426950408889634f;
    float pmax = p0[0];
#pragma unroll
    for (int r = 1; r < 16; ++r) pmax = fmaxf(pmax, p0[r]);
#pragma unroll
    for (int r = 0; r < 16; ++r) pmax = fmaxf(pmax, p1[r]);
    { auto rr = __builtin_amdgcn_permlane32_swap(__float_as_uint(pmax), __float_as_uint(pmax), false, false);
      pmax = fmaxf(__uint_as_float(rr[0]), __uint_as_float(rr[1])); }
    if (__builtin_expect(__all(pmax - m_reg <= THR / SCALE), 1)) { mn = m_reg; alpha = 1.f; }
    else { mn = fmaxf(m_reg, pmax); alpha = __builtin_amdgcn_exp2f((m_reg - mn) * C); m_reg = mn; }
    const float mnC = -mn * C;
#pragma unroll
    for (int r = 0; r < 16; ++r) p0[r] = fmaf(p0[r], C, mnC);
#pragma unroll
    for (int r = 0; r < 16; ++r) p1[r] = fmaf(p1[r], C, mnC);
#pragma unroll
    for (int r = 0; r < 16; ++r) p0[r] = __builtin_amdgcn_exp2f(p0[r]);
}
__device__ __forceinline__ void finishSM(f32x16& p0, f32x16& p1, float alpha, float& l_reg, bf16x8& pa0, bf16x8& pa1, bf16x8& pa2, bf16x8& pa3) {
#pragma unroll
    for (int r = 0; r < 16; ++r) p1[r] = __builtin_amdgcn_exp2f(p1[r]);
    float ps = 0;
#pragma unroll
    for (int r = 0; r < 16; ++r) ps += p0[r];
#pragma unroll
    for (int r = 0; r < 16; ++r) ps += p1[r];
    { auto rr = __builtin_amdgcn_permlane32_swap(__float_as_uint(ps), __float_as_uint(ps), false, false);
      ps = __uint_as_float(rr[0]) + __uint_as_float(rr[1]); }
    l_reg = l_reg * alpha + ps;
#define AT_PK4(P, BASE, OUT) do { unsigned a0 = cvtpk(P[BASE + 0], P[BASE + 1]), a1 = cvtpk(P[BASE + 2], P[BASE + 3]);   \
    unsigned b0 = cvtpk(P[BASE + 4], P[BASE + 5]), b1 = cvtpk(P[BASE + 6], P[BASE + 7]);                              \
    auto r0 = __builtin_amdgcn_permlane32_swap(a0, b0, false, false); auto r1 = __builtin_amdgcn_permlane32_swap(a1, b1, false, false); \
    u32x4 w = {r0[0], r1[0], r0[1], r1[1]}; OUT = *reinterpret_cast<bf16x8*>(&w); } while (0)
    AT_PK4(p0, 0, pa0); AT_PK4(p0, 8, pa1); AT_PK4(p1, 0, pa2); AT_PK4(p1, 8, pa3);
#undef AT_PK4
}
template <int DK> __device__ __forceinline__ void qkt(f32x16& p0, f32x16& p1, const char* Ks, const bf16x8* qr, int r32, int hi) {
    p0 = f32x16{}; p1 = f32x16{};
#pragma unroll
    for (int d0 = 0; d0 < DK / 16; ++d0) { const int cb = (d0 * 16 + hi * 8) * 2;
        const bf16x8 b0 = *reinterpret_cast<const bf16x8*>(Ks + kswz<DK>(r32, cb));
        const bf16x8 b1 = *reinterpret_cast<const bf16x8*>(Ks + kswz<DK>(32 + r32, cb));
        p0 = __builtin_amdgcn_mfma_f32_32x32x16_bf16(b0, qr[d0], p0, 0, 0, 0);
        p1 = __builtin_amdgcn_mfma_f32_32x32x16_bf16(b1, qr[d0], p1, 0, 0, 0); }
}
__device__ __forceinline__ int v_st(int k, int c) { const int kk = (k & ~0xC) | ((k & 4) << 1) | ((k & 8) >> 1); return ((kk >> 3) * 4 + (c >> 5)) * 512 + ((kk & 7) * 32 + (c & 31)) * 2; }
__device__ __forceinline__ int v_rd_base(int lane) { return ((lane & 3) << 3) | (((lane >> 2) & 3) << 6) | (((lane >> 4) & 1) << 5) | (((lane >> 5) & 1) << 8); }
constexpr int v_rd_off(int d0, int ks, int half) { return d0 * 512 + ks * 4096 + half * 2048; }
template <int OFF> __device__ __forceinline__ s16x4 tr_read(int vb) {
    s16x4 r; asm volatile("ds_read_b64_tr_b16 %0, %1 offset:%2" : "=&v"(r) : "v"(vb), "i"(OFF) : "memory"); return r;
}
template <int D0> __device__ __forceinline__ void pv_one(f32x16& od, int vb, bf16x8 pa0, bf16x8 pa1, bf16x8 pa2, bf16x8 pa3) {
    const s16x4 l0 = tr_read<v_rd_off(D0, 0, 0)>(vb), h0 = tr_read<v_rd_off(D0, 0, 1)>(vb), l1 = tr_read<v_rd_off(D0, 1, 0)>(vb), h1 = tr_read<v_rd_off(D0, 1, 1)>(vb);
    const s16x4 l2 = tr_read<v_rd_off(D0, 2, 0)>(vb), h2 = tr_read<v_rd_off(D0, 2, 1)>(vb), l3 = tr_read<v_rd_off(D0, 3, 0)>(vb), h3 = tr_read<v_rd_off(D0, 3, 1)>(vb);
    asm volatile("s_waitcnt lgkmcnt(0)" ::: "memory"); AT_SBAR();
#define AT_PK(L, H) (bf16x8){L[0], L[1], L[2], L[3], H[0], H[1], H[2], H[3]}
    od = __builtin_amdgcn_mfma_f32_32x32x16_bf16(pa0, AT_PK(l0, h0), od, 0, 0, 0);
    od = __builtin_amdgcn_mfma_f32_32x32x16_bf16(pa1, AT_PK(l1, h1), od, 0, 0, 0);
    od = __builtin_amdgcn_mfma_f32_32x32x16_bf16(pa2, AT_PK(l2, h2), od, 0, 0, 0);
    od = __builtin_amdgcn_mfma_f32_32x32x16_bf16(pa3, AT_PK(l3, h3), od, 0, 0, 0);
#undef AT_PK
}
__device__ __forceinline__ void pv_d0(f32x16* o, int vb, bf16x8 pa0, bf16x8 pa1, bf16x8 pa2, bf16x8 pa3) {
    pv_one<0>(o[0], vb, pa0, pa1, pa2, pa3); pv_one<1>(o[1], vb, pa0, pa1, pa2, pa3); pv_one<2>(o[2], vb, pa0, pa1, pa2, pa3); pv_one<3>(o[3], vb, pa0, pa1, pa2, pa3);
}

template <int DK>
__device__ __forceinline__ void attn_pass(const bf16_t* Qb, int ldq, const bf16_t* Kh, int ldk, const bf16_t* Vh, int ldv, int seq, char* lds, f32x16 (&o)[4]) {
    int tid_o = threadIdx.x; asm volatile("" : "+v"(tid_o)); const int tid = tid_o, wid = tid >> 6, lane = tid & 63, r32 = lane & 31, hi = lane >> 5;
    char* V_lds = lds; char* K_lds = lds + 2 * SHM_V;
    float* wsf = (float*)(lds + 2 * SHM_V + 2 * SHM_K) + wid * 64; float* li_l = wsf; float* al_l = wsf + 32;
    float m_reg = -1e30f, l_reg = 0;
#pragma unroll
    for (int d = 0; d < 4; ++d) o[d] = f32x16{};
    bf16x8 qr[DK / 16];
    const bf16_t* Qw = Qb + (size_t)(wid * QBLK + r32) * ldq + hi * 8;
#pragma unroll
    for (int d0 = 0; d0 < DK / 16; ++d0) qr[d0] = *reinterpret_cast<const bf16x8*>(Qw + d0 * 16);
    const int sr = tid >> 4, sc = (tid & 15) * 8, vst0 = v_st(sr, sc), vst1 = v_st(32 + sr, sc);
    const int kr64 = tid >> 3, kc64 = (tid & 7) * 8;
    const int vb0 = (int)(uintptr_t)V_lds + v_rd_base(lane);
    struct { bf16x8 vs0, vs1, ks0, ks1; } sr_[2];
#define AT_SLOAD(i, k0) do { sr_[i].vs0 = *reinterpret_cast<const bf16x8*>(&Vh[(size_t)((k0) + sr) * ldv + sc]); sr_[i].vs1 = *reinterpret_cast<const bf16x8*>(&Vh[(size_t)((k0) + 32 + sr) * ldv + sc]); \
    if constexpr (DK == 128) { sr_[i].ks0 = *reinterpret_cast<const bf16x8*>(&Kh[(size_t)((k0) + sr) * ldk + sc]); sr_[i].ks1 = *reinterpret_cast<const bf16x8*>(&Kh[(size_t)((k0) + 32 + sr) * ldk + sc]); } \
    else { sr_[i].ks0 = *reinterpret_cast<const bf16x8*>(&Kh[(size_t)((k0) + kr64) * ldk + kc64]); } } while (0)
#define AT_SWRITE(b, i) do { *(bf16x8*)(V_lds + (b) * SHM_V + vst0) = sr_[i].vs0; *(bf16x8*)(V_lds + (b) * SHM_V + vst1) = sr_[i].vs1; \
    if constexpr (DK == 128) { *(bf16x8*)(K_lds + (b) * SHM_K + kswz<128>(sr, sc * 2)) = sr_[i].ks0; *(bf16x8*)(K_lds + (b) * SHM_K + kswz<128>(32 + sr, sc * 2)) = sr_[i].ks1; } \
    else { *(bf16x8*)(K_lds + (b) * SHM_K + kswz<64>(kr64, kc64 * 2)) = sr_[i].ks0; } } while (0)
#define AT_SWAIT() do { if constexpr (DK == 128) asm volatile("s_waitcnt vmcnt(4)" ::: "memory"); else asm volatile("s_waitcnt vmcnt(3)" ::: "memory"); } while (0)
#define AT_RESC(a) do { if (__any((a) < 1.f)) { if (hi == 0) al_l[r32] = (a); asm volatile("s_waitcnt lgkmcnt(0)" ::: "memory"); \
    _Pragma("unroll") for (int d = 0; d < 4; ++d) _Pragma("unroll") for (int r = 0; r < 16; ++r) o[d][r] *= al_l[crow(r, hi)]; } } while (0)
    f32x16 pA0, pA1, pB0, pB1; float mnA, mnB, alA, alB; bf16x8 pa0, pa1, pa2, pa3; const int NT = seq / KVBLK;
    __syncthreads();
    AT_SLOAD(0, 0); asm volatile("s_waitcnt vmcnt(0)" ::: "memory"); AT_SWRITE(0, 0); __syncthreads();
    qkt<DK>(pA0, pA1, K_lds, qr, r32, hi); partialSM<DK>(pA0, pA1, m_reg, mnA, alA);
    AT_SLOAD(1, KVBLK); if (2 < NT) AT_SLOAD(0, 2 * KVBLK);
    AT_SWAIT(); AT_SWRITE(1, 1); __syncthreads();
    for (int j = 1; j + 1 < NT; j += 2) {
        AT_SBAR(); qkt<DK>(pB0, pB1, K_lds + SHM_K, qr, r32, hi);
        finishSM(pA0, pA1, alA, l_reg, pa0, pa1, pa2, pa3); AT_SBAR();
        AT_SLOAD(1, (j + 2) * KVBLK); AT_SBAR();
        pv_d0(o, vb0, pa0, pa1, pa2, pa3); partialSM<DK>(pB0, pB1, m_reg, mnB, alB);
        __syncthreads(); AT_SWAIT(); AT_SWRITE(0, 0);
        AT_RESC(alB); __syncthreads();
        AT_SBAR(); qkt<DK>(pA0, pA1, K_lds, qr, r32, hi);
        finishSM(pB0, pB1, alB, l_reg, pa0, pa1, pa2, pa3); AT_SBAR();
        if (j + 3 < NT) AT_SLOAD(0, (j + 3) * KVBLK); AT_SBAR();
        pv_d0(o, vb0 + SHM_V, pa0, pa1, pa2, pa3); partialSM<DK>(pA0, pA1, m_reg, mnA, alA);
        __syncthreads(); AT_SWAIT(); AT_SWRITE(1, 1);
        AT_RESC(alA); __syncthreads();
    }
    AT_SBAR(); qkt<DK>(pB0, pB1, K_lds + SHM_K, qr, r32, hi);
    finishSM(pA0, pA1, alA, l_reg, pa0, pa1, pa2, pa3); AT_SBAR();
    pv_d0(o, vb0, pa0, pa1, pa2, pa3); partialSM<DK>(pB0, pB1, m_reg, mnB, alB);
    __syncthreads(); AT_RESC(alB);
    finishSM(pB0, pB1, alB, l_reg, pa0, pa1, pa2, pa3); AT_SBAR();
    pv_d0(o, vb0 + SHM_V, pa0, pa1, pa2, pa3);
    if (hi == 0) li_l[r32] = l_reg; asm volatile("s_waitcnt lgkmcnt(0)" ::: "memory");
#pragma unroll
    for (int r = 0; r < 16; ++r) { const float rl = __builtin_amdgcn_rcpf(li_l[crow(r, hi)]);
#pragma unroll
        for (int d = 0; d < 4; ++d) o[d][r] *= rl; }
#undef AT_SLOAD
#undef AT_SWRITE
#undef AT_SWAIT
#undef AT_RESC
}
}

__device__ __forceinline__ void phase3(const Params& p, unsigned char* lds_u) {
    char* lds = (char*)lds_u;
    int tid_o = threadIdx.x; asm volatile("" : "+v"(tid_o)); const int tid = tid_o;
    int* s_unit = (int*)(lds + 67 * 1024);
    unsigned* ctr = (unsigned*)(p.ws + WS_CTR);
    const bf16_t* z = (const bf16_t*)(p.ws + WS_Z);
    bf16_t* ob = (bf16_t*)(p.ws + WS_O);
    float* scr = p.out + (size_t)blockIdx.x * 32768; const unsigned voff = (unsigned)tid * 16u;
    for (;;) {
        __syncthreads();
        if (tid == 0) *s_unit = (int)atomicAdd(ctr, 1u);
        __syncthreads();
        const int u = *s_unit;
        if (u >= 768) break;
        f32x16 o[4];
        if (u < 128 || (u >= 256 && u < 512)) {
            int b, h, row0, seq, ldk; const bf16_t *K, *V;
            if (u < 128) { b = u >> 5; h = (u >> 2) & 7; row0 = NCTX + b * 1024 + (u & 3) * 256; seq = LKV; ldk = 1024;
                K = (const bf16_t*)(p.ws + WS_KA) + (size_t)b * LKV * 1024 + h * 128; V = (const bf16_t*)(p.ws + WS_VA) + (size_t)b * LKV * 1024 + h * 128; }
            else { const int v = u - 256; b = v >> 3; h = v & 7; row0 = b * 256; seq = 256; ldk = DIN;
                K = z + (size_t)row0 * DIN + ZKA + h * 128; V = z + (size_t)row0 * DIN + ZVA + h * 128; }
            const bf16_t* Q = z + (size_t)row0 * DIN + ZQA + h * 128;
#pragma unroll 1
            for (int cmap = 0; cmap < 2; ++cmap) {
                at::attn_pass<64>(Q + cmap * 64, DIN, K + cmap * 64, ldk, V, ldk, seq, lds, o);
                if (cmap == 0) {
                    unsigned voff2 = voff; asm volatile("" : "+v"(voff2));
#pragma unroll
                    for (int d = 0; d < 4; ++d)
#pragma unroll
                        for (int q = 0; q < 4; ++q) *(f32x4*)((char*)scr + (d * 4 + q) * 8192 + voff2) = (f32x4){o[d][4 * q], o[d][4 * q + 1], o[d][4 * q + 2], o[d][4 * q + 3]};
                }
            }
            int tid2 = tid; asm volatile("" : "+v"(tid2));
            const int wid = tid2 >> 6, lane = tid2 & 63, r32 = lane & 31, hi = lane >> 5;
            float la = p.lq1[h * 64 + lane] * p.lk1[h * 64 + lane], lb = p.lq2[h * 64 + lane] * p.lk2[h * 64 + lane];
            la = wave_sum(la); lb = wave_sum(lb);
            const float lam = __expf(la) - __expf(lb) + 0.2f;
#pragma unroll
            for (int d = 0; d < 4; ++d)
#pragma unroll
                for (int q = 0; q < 4; ++q) { const f32x4 t = *(const f32x4*)((const char*)scr + (d * 4 + q) * 8192 + (unsigned)(tid2 * 16));
                    o[d][4 * q] = t[0] - lam * o[d][4 * q]; o[d][4 * q + 1] = t[1] - lam * o[d][4 * q + 1]; o[d][4 * q + 2] = t[2] - lam * o[d][4 * q + 2]; o[d][4 * q + 3] = t[3] - lam * o[d][4 * q + 3]; }
            float sg[4];
#pragma unroll
            for (int d = 0; d < 4; ++d) sg[d] = p.subln[d * 32 + r32] * 0.8f;
#pragma unroll
            for (int r = 0; r < 16; ++r) {
                float ss = o[0][r] * o[0][r] + o[1][r] * o[1][r] + o[2][r] * o[2][r] + o[3][r] * o[3][r];
                ss += __shfl_xor(ss, 16); ss += __shfl_xor(ss, 8); ss += __shfl_xor(ss, 4); ss += __shfl_xor(ss, 2); ss += __shfl_xor(ss, 1);
                const float rstd = rsqrtf(ss * (1.0f / 128.0f) + EPS);
                const int row = row0 + wid * 32 + at::crow(r, hi);
#pragma unroll
                for (int d = 0; d < 4; ++d) { const int col = h * 128 + d * 32 + r32;
                    const float g = bf2f(z[(size_t)row * DIN + ZGA + col]);
                    ob[(size_t)row * DM + col] = f2bf(o[d][r] * rstd * sg[d] * silu_f(g)); }
            }
        } else {
            int b, h, row0, seq, ldk; const bf16_t *K, *V;
            if (u < 256) { const int v = u - 128; b = v >> 5; h = (v >> 2) & 7; row0 = NCTX + b * 1024 + (v & 3) * 256; seq = LKV; ldk = 256;
                K = (const bf16_t*)(p.ws + WS_KB) + (size_t)b * LKV * 256 + (h >> 2) * 128; V = (const bf16_t*)(p.ws + WS_VB) + (size_t)b * LKV * 256 + (h >> 2) * 128; }
            else { const int v = u - 512; b = v >> 3; h = v & 7; row0 = b * 256; seq = 256; ldk = DIN;
                K = z + (size_t)row0 * DIN + ZKB + (h >> 2) * 128; V = z + (size_t)row0 * DIN + ZVB + (h >> 2) * 128; }
            const bf16_t* Q = z + (size_t)row0 * DIN + ZQB + h * 128;
            at::attn_pass<128>(Q, DIN, K, ldk, V, ldk, seq, lds, o);
            int tid2 = tid; asm volatile("" : "+v"(tid2));
            const int wid = tid2 >> 6, lane = tid2 & 63, r32 = lane & 31, hi = lane >> 5;
#pragma unroll
            for (int r = 0; r < 16; ++r) { const int row = row0 + wid * 32 + at::crow(r, hi);
#pragma unroll
                for (int d = 0; d < 4; ++d) { const int col = h * 128 + d * 32 + r32;
                    const float g = bf2f(z[(size_t)row * DIN + ZGB + col]);
                    ob[(size_t)row * DM + 1024 + col] = f2bf(o[d][r] * silu_f(g)); } }
        }
    }
}

__device__ __forceinline__ void phase5(const Params& p) {
    int tid_o = threadIdx.x; asm volatile("" : "+v"(tid_o)); const int tid = tid_o, wid = tid >> 6, lane = tid & 63, G = gridDim.x, bid = blockIdx.x;
    for (int row = bid * 8 + wid; row < MTOK; row += G * 8) {
        float* yr = p.out + (size_t)row * DM;
        f32x4 v[8]; float ss = 0.f;
#pragma unroll
        for (int i = 0; i < 8; ++i) { v[i] = *(const f32x4*)(yr + i * 256 + lane * 4); ss += v[i][0] * v[i][0] + v[i][1] * v[i][1] + v[i][2] * v[i][2] + v[i][3] * v[i][3]; }
        ss = wave_sum(ss);
        const float rstd = rsqrtf(ss * (1.0f / DM) + EPS);
#pragma unroll
        for (int i = 0; i < 8; ++i) { const int col = i * 256 + lane * 4; const f32x4 g = *(const f32x4*)(p.g_final + col); *(f32x4*)(yr + col) = (v[i] * rstd) * g; }
    }
}

__global__ void __launch_bounds__(512, 2) mega_fwd(Params p) {
    extern __shared__ __attribute__((aligned(16))) unsigned char lds[];
    cg::grid_group grid = cg::this_grid();
    const int G = gridDim.x, c = blockIdx.x;
    phase0(p, lds);
    grid.sync();
    phase1(p);
    grid.sync();
    {
        pg8::Gemm g; g.A = (const bf16_t*)p.out; g.Bt = (const bf16_t*)(p.ws + WS_WIN); g.M = MTOK; g.N = DIN; g.K = DM;
        pg8::StaticOrder S; S.init(g.M, g.N, G, c);
        EpiZ E; E.O = (bf16_t*)(p.ws + WS_Z);
        pg8::gemm_phase<EpiZ, pg8::StaticOrder, false>((PG8_LAS unsigned char*)lds, g, S, E, nullptr);
    }
    grid.sync();
    phase2b(p);
    grid.sync();
    phase3(p, lds);
    grid.sync();
    {
        pg8::Gemm g; g.A = (const bf16_t*)(p.ws + WS_O); g.Bt = (const bf16_t*)(p.ws + WS_WOUT); g.M = MTOK; g.N = DM; g.K = DM;
        pg8::StaticOrder S; S.init(g.M, g.N, G, c);
        EpiRes E; E.xp = p.x_prompt; E.xs = p.x_sample; E.mod = (const float*)(p.ws + WS_MOD); E.out = p.out;
        pg8::gemm_phase<EpiRes, pg8::StaticOrder, false>((PG8_LAS unsigned char*)lds, g, S, E, nullptr);
    }
    grid.sync();
    phase5(p);
}

extern "C" void kernel_launch(void* const* d_in, const int* in_sizes, int n_in, void* d_out, int out_size, void* d_ws, size_t ws_size, hipStream_t stream) {
    static int grid_blocks = 0;
    if (grid_blocks == 0) {
        if (n_in != 21 || ws_size < WS_END) { fprintf(stderr, "kernel_launch: unexpected n_in %d / ws %zu\n", n_in, ws_size); grid_blocks = -1; return; }
        int dev = 0, cus = 0, per_cu = 0;
        hipGetDevice(&dev);
        hipDeviceGetAttribute(&cus, hipDeviceAttributeMultiprocessorCount, dev);
        if (hipFuncSetAttribute((const void*)mega_fwd, hipFuncAttributeMaxDynamicSharedMemorySize, LDS_BYTES) != hipSuccess) { fprintf(stderr, "kernel_launch: hipFuncSetAttribute failed\n"); grid_blocks = -1; return; }
        if (hipOccupancyMaxActiveBlocksPerMultiprocessor(&per_cu, (const void*)mega_fwd, 512, LDS_BYTES) != hipSuccess || per_cu < 1) { fprintf(stderr, "kernel_launch: occupancy query failed (%d)\n", per_cu); grid_blocks = -1; return; }
        grid_blocks = cus * per_cu;
        if (grid_blocks > 256) grid_blocks = 256;
    }
    if (grid_blocks < 0) return;
    Params p{};
    p.x_prompt = (const float*)d_in[0]; p.x_sample = (const float*)d_in[1]; p.cdk = (const float*)d_in[2]; p.cdv = (const float*)d_in[3]; p.cgk = (const float*)d_in[4]; p.cgv = (const float*)d_in[5];
    p.c = (const float*)d_in[6]; p.c_ctx = (const float*)d_in[7]; p.w_ada = (const float*)d_in[8]; p.b_ada = (const float*)d_in[9]; p.g_norm = (const float*)d_in[10]; p.w_in = (const float*)d_in[11];
    p.lq1 = (const float*)d_in[12]; p.lk1 = (const float*)d_in[13]; p.lq2 = (const float*)d_in[14]; p.lk2 = (const float*)d_in[15]; p.subln = (const float*)d_in[16]; p.qng = (const float*)d_in[17];
    p.kng = (const float*)d_in[18]; p.w_out = (const float*)d_in[19]; p.g_final = (const float*)d_in[20];
    p.out = (float*)d_out; p.ws = (unsigned char*)d_ws;
    void* args[] = {&p};
    hipError_t e = hipLaunchCooperativeKernel((const void*)mega_fwd, dim3(grid_blocks), dim3(512), args, LDS_BYTES, stream);
    if (e != hipSuccess) fprintf(stderr, "cooperative launch failed: %s (grid %d)\n", hipGetErrorString(e), grid_blocks);
}
```

```cpp
#include <hip/hip_runtime.h>
#include <hip/hip_cooperative_groups.h>
#include <cstdio>
#include <cstdint>
namespace cg = cooperative_groups;
namespace pg8 {
#define PG8_LAS __attribute__((address_space(3)))
typedef unsigned short bf16_t;
typedef short bf16x8 __attribute__((ext_vector_type(8)));
typedef float f32x4 __attribute__((ext_vector_type(4)));
typedef unsigned u32x4 __attribute__((ext_vector_type(4)));
constexpr int BM = 256, BK = 64, HALF = 128, HTB = HALF * BK * 2  , STAGE_BYTES = 8 * HTB, NXCD = 8, WGM = 8;

__host__ __device__ __forceinline__ int lds_byte(int r, int c) { const int st = (r >> 4) * 2 + (c >> 5), rr = r & 15, cc = c & 31, ob = rr * 64 + cc * 2; return st * 1024 + (ob ^ (((ob >> 9) & 1) << 5)); }
__host__ __device__ __forceinline__ void stage_rc(int b, int& R, int& C) { const int st = b / 1024, sb = b % 1024, swz = sb ^ (((sb >> 9) & 1) << 5); R = (st >> 1) * 16 + swz / 64; C = (st & 1) * 32 + (swz % 64) / 2; }
__host__ __device__ __forceinline__ int perm32(int rho) { const int n = rho >> 4, i = rho & 15; return 8 * (i >> 2) + 4 * n + (i & 3); }

struct Unit { int pm, pn; };
struct Gemm { const bf16_t* A; const bf16_t* Bt; int M, N, K; };

struct StaticOrder {
    int nM, nN, nwg, G, c;
    __host__ __device__ void init(int M, int N, int G_, int c_) { nM = M / BM; nN = N / BM; nwg = nM * nN; G = G_; c = c_; }
    __host__ __device__ bool next(int i, Unit& u) const {
        const long L = (long)i * G + c; if (L >= nwg) return false;
        int wgid = (int)L; { const int q = nwg / NXCD, r = nwg % NXCD, xcd = wgid % NXCD, off = wgid / NXCD; wgid = (xcd < r ? xcd * (q + 1) : r * (q + 1) + (xcd - r) * q) + off; }
        const int nig = WGM * nN, gid = wgid / nig, fm = gid * WGM, gsz = (nM - fm) < WGM ? (nM - fm) : WGM;
        u.pm = fm + ((wgid % nig) % gsz); u.pn = (wgid % nig) / gsz; return true;
    }
    __device__ __forceinline__ void a_ready(const Unit&) const {}
    __device__ __forceinline__ void done(const Unit&) const {}
};
struct CountedOrder : StaticOrder {
    const unsigned* ready; unsigned need; unsigned* tmo;
    __device__ __forceinline__ void a_ready(const Unit& u) const {
        if (threadIdx.x < 64) {
            const unsigned long long t0 = __builtin_amdgcn_s_memrealtime(); unsigned polls = 0;
            while ((unsigned)__builtin_amdgcn_readfirstlane(__hip_atomic_load(ready + 64 * u.pm, __ATOMIC_RELAXED, __HIP_MEMORY_SCOPE_AGENT)) < need) {
                if ((++polls & 255u) == 0u && __builtin_amdgcn_readfirstlane(__hip_atomic_load(tmo, __ATOMIC_RELAXED, __HIP_MEMORY_SCOPE_AGENT)) != 0u) break;
                if (__builtin_amdgcn_s_memrealtime() - t0 > 2000000ull) {
                    if (threadIdx.x == 0) { unsigned expect = 0u; __hip_atomic_compare_exchange_strong(tmo + 1, &expect, 0x600u | (unsigned)(u.pm & 0xff), __ATOMIC_RELAXED, __ATOMIC_RELAXED, __HIP_MEMORY_SCOPE_AGENT); __hip_atomic_store(tmo, 1u, __ATOMIC_RELAXED, __HIP_MEMORY_SCOPE_AGENT); }
                    break; }
                __builtin_amdgcn_s_sleep(2); }
            __builtin_amdgcn_fence(__ATOMIC_ACQUIRE, "agent");
            asm volatile("s_waitcnt vmcnt(0)" ::: "memory");
        }
#if !defined(BROKEN_HOOK_NO_BARRIER)
        asm volatile("" ::: "memory"); __builtin_amdgcn_s_barrier(); asm volatile("" ::: "memory");
#endif
    }
};

__device__ __forceinline__ unsigned cvt_pk_bf16(float lo, float hi) { unsigned r; asm volatile("v_cvt_pk_bf16_f32 %0, %1, %2" : "=v"(r) : "v"(lo), "v"(hi)); return r; }
typedef float f32x2 __attribute__((ext_vector_type(2)));
__device__ __forceinline__ f32x2 gelu_pk(f32x2 v) {
    const f32x2 av = __builtin_elementwise_abs(v), d = av * 0.2316418882f + 1.0f;
    f32x2 t; t.x = __builtin_amdgcn_rcpf(d.x); t.y = __builtin_amdgcn_rcpf(d.y);
    f32x2 q = t * 0.5307027145f + (-0.7265760135f); q = q * t + 0.7107068705f; q = q * t + (-0.142248368f); q = q * t + 0.127414796f; q = q * t;
    const f32x2 s = (v * v) * (-0.72134752044f);
    f32x2 e; e.x = __builtin_amdgcn_exp2f(s.x); e.y = __builtin_amdgcn_exp2f(s.y);
    const f32x2 m = v * (q * e), r = v - m;
    f32x2 o; o.x = v.x < 0.f ? m.x : r.x; o.y = v.y < 0.f ? m.y : r.y; return o;
}

template <class Epi, class Sched, bool STAMP = false>
__device__ __forceinline__ void gemm_phase(PG8_LAS unsigned char* lds, const Gemm g, const Sched& S, const Epi& E, unsigned long long* stamps) {
    int tid_o = threadIdx.x; asm volatile("" : "+v"(tid_o)); const int tid = tid_o, wid = __builtin_amdgcn_readfirstlane(tid >> 6), lane = tid & 63, wr = wid >> 2, wc = wid & 3, fr = lane & 15, fq = lane >> 4;
    const int K = g.K, nt = K / BK;
    int ts_lo = 0, ts_hi = 0, nts = 0; const unsigned long long rt_entry = STAMP ? (unsigned long long)wall_clock64() : 0ull;
#define PG8_STAMP() do { if (STAMP && wid == 0 && nts < 64) { const unsigned long long _c = (unsigned long long)clock64(); \
        ts_lo = (lane == nts) ? (int)(unsigned)_c : ts_lo; ts_hi = (lane == nts) ? (int)(unsigned)(_c >> 32) : ts_hi; ++nts; } } while (0)
    PG8_STAMP();
    unsigned voffA[2], voffB[2];
#pragma unroll
    for (int i = 0; i < 2; ++i) { int R, C; stage_rc(tid * 16 + i * 8192, R, C); const int Rb = Epi::PERM ? ((R & ~31) + perm32(R & 31)) : R;
        voffA[i] = (unsigned)(R * K + C) * 2u; voffB[i] = (unsigned)(Rb * K + C) * 2u; }
    const size_t kstep = (size_t)(BK * 2);
    const size_t hstep = (size_t)HALF * K * 2;
    const size_t tstep = 2 * hstep;
    const unsigned ldsw = (unsigned)wid * 1024u;
    const int aoff = lds_byte(wr * 64 + fr, fq * 8), boff = lds_byte(wc * 32 + fr, fq * 8);
#define PG8_SA(b, h) (((b) * 2 + (h)) * HTB)
#define PG8_SB(b, h) ((4 + (b) * 2 + (h)) * HTB)
#define PG8_STAGE(bufoff, gbase, voff) do { _Pragma("unroll") for (int _i = 0; _i < 2; ++_i) \
        __builtin_amdgcn_global_load_lds((const unsigned*)((const char*)(gbase) + (voff)[_i]), (PG8_LAS unsigned*)(lds + (bufoff) + ldsw + _i * 8192), 16, 0, 0); } while (0)
#define PG8_LDA(dst, b, h) do { _Pragma("unroll") for (int m = 0; m < 4; ++m) _Pragma("unroll") for (int k = 0; k < 2; ++k) dst[m][k] = *(const PG8_LAS bf16x8*)(lds + PG8_SA(b, h) + aoff + m * 2048 + k * 1024); } while (0)
#define PG8_LDB(dst, b, h) do { _Pragma("unroll") for (int n = 0; n < 2; ++n) _Pragma("unroll") for (int k = 0; k < 2; ++k) dst[n][k] = *(const PG8_LAS bf16x8*)(lds + PG8_SB(b, h) + boff + n * 2048 + k * 1024); } while (0)
#define PG8_MMA(ai, bj, At, Bt) do { __builtin_amdgcn_s_setprio(1); _Pragma("unroll") for (int m = 0; m < 4; ++m) _Pragma("unroll") for (int n = 0; n < 2; ++n) _Pragma("unroll") for (int k = 0; k < 2; ++k) \
        acc[ai][bj][m][n] = __builtin_amdgcn_mfma_f32_16x16x32_bf16(Bt[n][k], At[m][k], acc[ai][bj][m][n], 0, 0, 0); __builtin_amdgcn_s_setprio(0); } while (0)
#define PG8_WAIT_V(n) asm volatile("s_waitcnt vmcnt(" #n ")" ::: "memory")
#define PG8_WAIT_L(n) asm volatile("s_waitcnt lgkmcnt(" #n ")" ::: "memory")
#define PG8_BAR __builtin_amdgcn_s_barrier()
#define PG8_SCHED __builtin_amdgcn_sched_barrier(0)
    Unit cur, nxt; int ui = 0;
    if (!S.next(0, cur)) return;
    f32x4 acc[2][2][4][2];
#pragma unroll
    for (int a = 0; a < 2; ++a)
#pragma unroll
        for (int b = 0; b < 2; ++b)
#pragma unroll
            for (int m = 0; m < 4; ++m)
#pragma unroll
                for (int n = 0; n < 2; ++n) acc[a][b][m][n] = (f32x4){0.f, 0.f, 0.f, 0.f};
    bf16x8 At[4][2], B0[2][2], B1[2][2];
    const char* cA = (const char*)g.A + (size_t)cur.pm * tstep; const char* cB = (const char*)g.Bt + (size_t)cur.pn * tstep;
    S.a_ready(cur);
    PG8_STAGE(PG8_SB(0, 0), cB, voffB); PG8_STAGE(PG8_SA(0, 0), cA, voffA); PG8_STAGE(PG8_SB(0, 1), cB + hstep, voffB); PG8_STAGE(PG8_SA(0, 1), cA + hstep, voffA);
    if (wr == 1) PG8_BAR;
    PG8_WAIT_V(4); PG8_BAR;
    PG8_STAGE(PG8_SB(1, 0), cB + kstep, voffB); PG8_STAGE(PG8_SA(1, 0), cA + kstep, voffA); PG8_STAGE(PG8_SB(1, 1), cB + hstep + kstep, voffB);
    PG8_WAIT_V(6); PG8_BAR;
    PG8_STAMP();
    for (;;) {
        const bool has_next = S.next(ui + 1, nxt);
        const char* nA = has_next ? (const char*)g.A + (size_t)nxt.pm * tstep : cA; const char* nB = has_next ? (const char*)g.Bt + (size_t)nxt.pn * tstep : cB;
        for (int t = 0; t < nt; t += 2) {
            const bool last = (t == nt - 2);
            const char* a1 = cA + (size_t)(t + 1) * kstep;
            const char* a2 = last ? nA : cA + (size_t)(t + 2) * kstep; const char* b2 = last ? nB : cB + (size_t)(t + 2) * kstep;
            const char* a3 = a2 + kstep; const char* b3 = b2 + kstep;
            if (last && has_next) S.a_ready(nxt);
            PG8_LDB(B0, 0, 0); PG8_SCHED; PG8_LDA(At, 0, 0); PG8_STAGE(PG8_SA(1, 1), a1 + hstep, voffA);
            PG8_WAIT_L(8); PG8_BAR; PG8_WAIT_L(0); PG8_MMA(0, 0, At, B0); PG8_BAR; PG8_SCHED;
            PG8_LDB(B1, 0, 1); PG8_STAGE(PG8_SB(0, 0), b2, voffB);
            PG8_BAR; PG8_WAIT_L(0); PG8_MMA(0, 1, At, B1); PG8_BAR;
            PG8_LDA(At, 0, 1); PG8_STAGE(PG8_SA(0, 0), a2, voffA);
            PG8_BAR; PG8_WAIT_L(0); PG8_MMA(1, 0, At, B0); PG8_BAR; PG8_SCHED;
            PG8_STAGE(PG8_SB(0, 1), b2 + hstep, voffB);
            PG8_WAIT_V(6); PG8_BAR; PG8_MMA(1, 1, At, B1); PG8_BAR;
            PG8_LDB(B0, 1, 0); PG8_SCHED; PG8_LDA(At, 1, 0); PG8_STAGE(PG8_SA(0, 1), a2 + hstep, voffA);
            PG8_WAIT_L(8); PG8_BAR; PG8_WAIT_L(0); PG8_MMA(0, 0, At, B0); PG8_BAR; PG8_SCHED;
            PG8_LDB(B1, 1, 1); PG8_STAGE(PG8_SB(1, 0), b3, voffB);
            PG8_BAR; PG8_WAIT_L(0); PG8_MMA(0, 1, At, B1); PG8_BAR;
            PG8_LDA(At, 1, 1); PG8_STAGE(PG8_SA(1, 0), a3, voffA);
            PG8_BAR; PG8_WAIT_L(0); PG8_MMA(1, 0, At, B0); PG8_BAR; PG8_SCHED;
            PG8_STAGE(PG8_SB(1, 1), b3 + hstep, voffB);
            PG8_WAIT_V(6); PG8_BAR; PG8_MMA(1, 1, At, B1); PG8_BAR;
        }
        PG8_STAMP();
        if constexpr (!Epi::AFTER_DRAIN) { E(acc, cur, wr, wc, fr, fq); S.done(cur); }
        PG8_STAMP();
        if (!has_next) break;
#pragma unroll
        for (int a = 0; a < 2; ++a)
#pragma unroll
            for (int b = 0; b < 2; ++b)
#pragma unroll
                for (int m = 0; m < 4; ++m)
#pragma unroll
                    for (int n = 0; n < 2; ++n) acc[a][b][m][n] = (f32x4){0.f, 0.f, 0.f, 0.f};
        cur = nxt; cA = nA; cB = nB; ++ui;
    }
    PG8_WAIT_V(0);
    if (wr == 0) PG8_BAR;
    PG8_BAR;
    if constexpr (Epi::AFTER_DRAIN) { E.fused(acc, cur, wr, wc, fr, fq, lds, wid, lane); S.done(cur); }
    PG8_STAMP();
    if (STAMP && wid == 0) { stamps[lane] = lane < nts ? (((unsigned long long)(unsigned)ts_hi << 32) | (unsigned)ts_lo) : 0ull;
        if (lane == 62) stamps[62] = rt_entry; if (lane == 63) stamps[63] = (unsigned long long)wall_clock64(); }
#undef PG8_STAMP
#undef PG8_SA
#undef PG8_SB
#undef PG8_STAGE
#undef PG8_LDA
#undef PG8_LDB
#undef PG8_MMA
#undef PG8_WAIT_V
#undef PG8_WAIT_L
#undef PG8_BAR
#undef PG8_SCHED
}
}

typedef unsigned short bf16_t;
constexpr int DM = 2048, NCTX = 8192, NLAT = 4096, MTOK = 12288, DIN = 6656, LKV = 1536;
constexpr int ZQA = 0, ZKA = 1024, ZVA = 2048, ZGA = 3072, ZQB = 4096, ZKB = 5120, ZVB = 5376, ZGB = 5632;
constexpr float EPS = 1e-6f;
constexpr size_t MiB = 1048576;
constexpr size_t WS_MOD = 0, WS_CTR = 512 * 1024, WS_WOUT = 1 * MiB, WS_KA = 9 * MiB, WS_VA = 21 * MiB, WS_KB = 33 * MiB, WS_VB = 36 * MiB,
                 WS_Z = 40 * MiB, WS_O = 196 * MiB, WS_WIN = WS_O, WS_END = 244 * MiB;
constexpr size_t OUT_Y = 0, OUT_NDK = (size_t)MTOK * DM, OUT_NDV = OUT_NDK + (size_t)NCTX * 1024, OUT_NGK = OUT_NDV + (size_t)NCTX * 1024, OUT_NGV = OUT_NGK + (size_t)NCTX * 256;
constexpr int LDS_BYTES = 140 * 1024;

struct Params {
    const float *x_prompt, *x_sample, *cdk, *cdv, *cgk, *cgv, *c, *c_ctx, *w_ada, *b_ada, *g_norm, *w_in, *lq1, *lk1, *lq2, *lk2, *subln, *qng, *kng, *w_out, *g_final;
    float* out; unsigned char* ws;
};

typedef short bf16x8 __attribute__((ext_vector_type(8)));
typedef short s16x4 __attribute__((ext_vector_type(4)));
typedef float f32x4 __attribute__((ext_vector_type(4)));
typedef float f32x16 __attribute__((ext_vector_type(16)));
typedef unsigned u32x4 __attribute__((ext_vector_type(4)));
typedef unsigned u32x2 __attribute__((ext_vector_type(2)));

__device__ __forceinline__ unsigned cvtpk(float lo, float hi) { unsigned r; asm volatile("v_cvt_pk_bf16_f32 %0, %1, %2" : "=v"(r) : "v"(lo), "v"(hi)); return r; }
__device__ __forceinline__ float bf_lo(unsigned w) { return __uint_as_float(w << 16); }
__device__ __forceinline__ float bf_hi(unsigned w) { return __uint_as_float(w & 0xffff0000u); }
__device__ __forceinline__ float bf2f(bf16_t b) { return __uint_as_float(((unsigned)b) << 16); }
__device__ __forceinline__ bf16_t f2bf(float f) { unsigned u = __float_as_uint(f); u += 0x7fffu + ((u >> 16) & 1u); return (bf16_t)(u >> 16); }
__device__ __forceinline__ float wave_sum(float v) {
    v += __shfl_xor(v, 32); v += __shfl_xor(v, 16); v += __shfl_xor(v, 8); v += __shfl_xor(v, 4); v += __shfl_xor(v, 2); v += __shfl_xor(v, 1); return v;
}
__device__ __forceinline__ float silu_f(float v) { return v / (1.0f + __expf(-v)); }
__device__ __forceinline__ void sincos_rev(float a, float& s, float& c) { float r = a * 0.15915494309189535f; r = r - floorf(r); s = __builtin_amdgcn_sinf(r); c = __builtin_amdgcn_cosf(r); }

struct EpiZ {
    static constexpr bool PERM = true, AFTER_DRAIN = false;
    bf16_t* O;
    __device__ __forceinline__ void operator()(const pg8::f32x4 (&acc)[2][2][4][2], const pg8::Unit& u, int wr, int wc, int fr, int fq) const {
        const int row0 = u.pm * 256 + wr * 64 + fr; const int col0 = u.pn * 256 + wc * 32 + 8 * fq;
#pragma unroll
        for (int ai = 0; ai < 2; ++ai)
#pragma unroll
            for (int m = 0; m < 4; ++m) { bf16_t* rowp = O + (size_t)(row0 + ai * 128 + m * 16) * DIN + col0;
#pragma unroll
                for (int bj = 0; bj < 2; ++bj) { const pg8::f32x4 v0 = acc[ai][bj][m][0], v1 = acc[ai][bj][m][1];
                    u32x4 w; w.x = cvtpk(v0[0], v0[1]); w.y = cvtpk(v0[2], v0[3]); w.z = cvtpk(v1[0], v1[1]); w.w = cvtpk(v1[2], v1[3]);
                    *(u32x4*)(rowp + bj * 128) = w; } }
    }
};
__host__ __device__ __forceinline__ int phys_col(int n) {
    const int tile = n >> 8, x = n & 255, bj = x >> 7, y = x & 127;
    if (tile < 8) { const int c = y >> 6, nn = (y >> 5) & 1, s = (y >> 4) & 1, fq = (y >> 2) & 3, j = y & 3; return tile * 256 + 128 * bj + 32 * (2 * c + s) + 8 * fq + 4 * nn + j; }
    if (tile >= 16 && tile <= 20) { const int nn = y >> 6, wc = (y >> 4) & 3, fq = (y >> 2) & 3, j = y & 3; return tile * 256 + 128 * bj + 32 * wc + 8 * fq + 4 * nn + j; }
    return n;
}
struct EpiFused {
    static constexpr bool PERM = true, AFTER_DRAIN = false;
    bf16_t* z; bf16_t* KA; bf16_t* VA; bf16_t* KB; bf16_t* VB; float* out; const float* qng; const float* kng; PG8_LAS float* P;
    __device__ __forceinline__ void operator()(const pg8::f32x4 (&acc)[2][2][4][2], const pg8::Unit& u, int wr, int wc, int fr, int fq) const {
        const int pn = u.pn, pm = u.pm; const bool lat = pm >= 32;
        const int rl0 = wr * 64 + fr, grow0 = pm * 256 + rl0;
        const int b = lat ? (pm - 32) >> 2 : 0, pos0 = lat ? ((pm - 32) & 3) * 256 + rl0 : 0;
        const float L2T = 13.287712379549449f;
        if (pn < 8) {
            const int cl = 64 * (wc >> 1) + 16 * (wc & 1) + 4 * fq; const bool rowfreq = (wc & 1) == 0;
            float inv[4];
#pragma unroll
            for (int j = 0; j < 4; ++j) inv[j] = __builtin_amdgcn_exp2f(-(float)(4 * fq + j) * (L2T / 16.0f));
#pragma unroll
            for (int ai = 0; ai < 2; ++ai)
#pragma unroll
                for (int m = 0; m < 4; ++m) { const int row = grow0 + 128 * ai + 16 * m, pos = pos0 + 128 * ai + 16 * m;
                    float cs[4], sn[4];
                    if (lat) { const float pv = (float)(rowfreq ? (pos >> 6) : (pos & 63));
#pragma unroll
                        for (int j = 0; j < 4; ++j) sincos_rev(pv * inv[j], sn[j], cs[j]); }
#pragma unroll
                    for (int bj = 0; bj < 2; ++bj) { const pg8::f32x4 x1 = acc[ai][bj][m][0], x2 = acc[ai][bj][m][1]; pg8::f32x4 o1 = x1, o2 = x2;
                        if (lat) {
#pragma unroll
                            for (int j = 0; j < 4; ++j) { o1[j] = x1[j] * cs[j] - x2[j] * sn[j]; o2[j] = x1[j] * sn[j] + x2[j] * cs[j]; } }
                        const int col = (pn & 3) * 256 + 128 * bj + cl;
                        u32x2 w1, w2; w1.x = cvtpk(o1[0], o1[1]); w1.y = cvtpk(o1[2], o1[3]); w2.x = cvtpk(o2[0], o2[1]); w2.y = cvtpk(o2[2], o2[3]);
                        if (pn < 4) { bf16_t* d = z + (size_t)row * DIN + ZQA + col; *(u32x2*)d = w1; *(u32x2*)(d + 32) = w2; }
                        else if (!lat) { bf16_t* d = z + (size_t)row * DIN + ZKA + col; *(u32x2*)d = w1; *(u32x2*)(d + 32) = w2;
                            float* o = out + OUT_NDK + (size_t)row * 1024 + col; *(pg8::f32x4*)o = o1; *(pg8::f32x4*)(o + 32) = o2; }
                        else { bf16_t* d = KA + ((size_t)(b * LKV + pos)) * 1024 + col; *(u32x2*)d = w1; *(u32x2*)(d + 32) = w2; } } }
        } else if (pn >= 16 && pn <= 20) {
            const bool isq = pn < 20; const float* gsrc = isq ? qng : kng;
            const int cl = 16 * wc + 4 * fq;
            const pg8::f32x4 g1 = *(const pg8::f32x4*)(gsrc + cl), g2 = *(const pg8::f32x4*)(gsrc + cl + 64);
#pragma unroll
            for (int ai = 0; ai < 2; ++ai)
#pragma unroll
                for (int m = 0; m < 4; ++m)
#pragma unroll
                    for (int bj = 0; bj < 2; ++bj) { const pg8::f32x4 x1 = acc[ai][bj][m][0], x2 = acc[ai][bj][m][1];
                        float s = (x1[0] * x1[0] + x1[1] * x1[1]) + (x1[2] * x1[2] + x1[3] * x1[3]) + (x2[0] * x2[0] + x2[1] * x2[1]) + (x2[2] * x2[2] + x2[3] * x2[3]);
                        s += __shfl_xor(s, 16); s += __shfl_xor(s, 32);
                        if (fq == 0) P[((128 * ai + rl0 + 16 * m) * 2 + bj) * 4 + wc] = s; }
            asm volatile("s_waitcnt lgkmcnt(0)" ::: "memory"); __builtin_amdgcn_s_barrier(); asm volatile("" ::: "memory");
            const bool rowfreq = wc < 2;
            float inv[4];
#pragma unroll
            for (int j = 0; j < 4; ++j) inv[j] = __builtin_amdgcn_exp2f(-(float)((16 * wc + 4 * fq + j) & 31) * (L2T / 32.0f));
#pragma unroll
            for (int ai = 0; ai < 2; ++ai)
#pragma unroll
                for (int m = 0; m < 4; ++m) { const int row = grow0 + 128 * ai + 16 * m, pos = pos0 + 128 * ai + 16 * m;
                    float cs[4], sn[4];
                    if (lat) { const float pv = (float)(rowfreq ? (pos >> 6) : (pos & 63));
#pragma unroll
                        for (int j = 0; j < 4; ++j) sincos_rev(pv * inv[j], sn[j], cs[j]); }
#pragma unroll
                    for (int bj = 0; bj < 2; ++bj) { const pg8::f32x4 x1 = acc[ai][bj][m][0], x2 = acc[ai][bj][m][1];
                        const pg8::f32x4 pp = *(const PG8_LAS pg8::f32x4*)(P + ((128 * ai + rl0 + 16 * m) * 2 + bj) * 4);
                        const float rstd = rsqrtf(((pp[0] + pp[1]) + (pp[2] + pp[3])) * (1.0f / 128.0f) + EPS);
                        const pg8::f32x4 y1 = x1 * rstd * g1, y2 = x2 * rstd * g2; pg8::f32x4 o1 = y1, o2 = y2;
                        if (lat) {
#pragma unroll
                            for (int j = 0; j < 4; ++j) { o1[j] = y1[j] * cs[j] - y2[j] * sn[j]; o2[j] = y1[j] * sn[j] + y2[j] * cs[j]; } }
                        u32x2 w1, w2; w1.x = cvtpk(o1[0], o1[1]); w1.y = cvtpk(o1[2], o1[3]); w2.x = cvtpk(o2[0], o2[1]); w2.y = cvtpk(o2[2], o2[3]);
                        if (isq) { bf16_t* d = z + (size_t)row * DIN + ZQB + (pn - 16) * 256 + 128 * bj + cl; *(u32x2*)d = w1; *(u32x2*)(d + 64) = w2; }
                        else if (!lat) { bf16_t* d = z + (size_t)row * DIN + ZKB + 128 * bj + cl; *(u32x2*)d = w1; *(u32x2*)(d + 64) = w2;
                            float* o = out + OUT_NGK + (size_t)row * 256 + 128 * bj + cl; *(pg8::f32x4*)o = o1; *(pg8::f32x4*)(o + 64) = o2; }
                        else { bf16_t* d = KB + ((size_t)(b * LKV + pos)) * 256 + 128 * bj + cl; *(u32x2*)d = w1; *(u32x2*)(d + 64) = w2; } } }
        } else {
            const int c8 = 32 * wc + 8 * fq;
            const bool gate = (pn >= 12 && pn < 16) || pn >= 22;
#pragma unroll
            for (int ai = 0; ai < 2; ++ai)
#pragma unroll
                for (int m = 0; m < 4; ++m) { const int row = grow0 + 128 * ai + 16 * m, pos = pos0 + 128 * ai + 16 * m;
#pragma unroll
                    for (int bj = 0; bj < 2; ++bj) { pg8::f32x4 v0 = acc[ai][bj][m][0], v1 = acc[ai][bj][m][1];
                        if (gate) {
#pragma unroll
                            for (int j = 0; j < 4; ++j) { v0[j] = silu_f(v0[j]); v1[j] = silu_f(v1[j]); } }
                        u32x4 w; w.x = cvtpk(v0[0], v0[1]); w.y = cvtpk(v0[2], v0[3]); w.z = cvtpk(v1[0], v1[1]); w.w = cvtpk(v1[2], v1[3]);
                        const int col = 128 * bj + c8;
                        if (gate) { *(u32x4*)(z + (size_t)row * DIN + (size_t)pn * 256 + col) = w; }
                        else if (pn < 12) {
                            const int vc = (pn - 8) * 256 + col;
                            if (!lat) { *(u32x4*)(z + (size_t)row * DIN + ZVA + vc) = w; float* o = out + OUT_NDV + (size_t)row * 1024 + vc; *(pg8::f32x4*)o = v0; *(pg8::f32x4*)(o + 4) = v1; }
                            else *(u32x4*)(VA + ((size_t)(b * LKV + pos)) * 1024 + vc) = w; }
                        else {
                            if (!lat) { *(u32x4*)(z + (size_t)row * DIN + ZVB + col) = w; float* o = out + OUT_NGV + (size_t)row * 256 + col; *(pg8::f32x4*)o = v0; *(pg8::f32x4*)(o + 4) = v1; }
                            else *(u32x4*)(VB + ((size_t)(b * LKV + pos)) * 256 + col) = w; } } }
        }
    }
};
struct EpiRes {
    static constexpr bool PERM = false, AFTER_DRAIN = false;
    const float* xp; const float* xs; const float* mod; float* out;
    __device__ __forceinline__ void operator()(const pg8::f32x4 (&acc)[2][2][4][2], const pg8::Unit& u, int wr, int wc, int fr, int fq) const {
        const int row0 = u.pm * 256 + wr * 64 + fr; const int col0 = u.pn * 256 + wc * 32 + 4 * fq;
        const int cnd = u.pm < 32 ? 0 : 1 + ((u.pm - 32) >> 2);
        const float* gate = mod + cnd * 6144 + 4096 + col0;
        pg8::f32x4 gv[2][2];
#pragma unroll
        for (int bj = 0; bj < 2; ++bj)
#pragma unroll
            for (int n = 0; n < 2; ++n) gv[bj][n] = *(const pg8::f32x4*)(gate + bj * 128 + n * 16);
#pragma unroll
        for (int ai = 0; ai < 2; ++ai)
#pragma unroll
            for (int m = 0; m < 4; ++m) { const int row = row0 + ai * 128 + m * 16;
                const float* xr = (row < NCTX ? xp + (size_t)row * DM : xs + (size_t)(row - NCTX) * DM) + col0;
                float* orow = out + (size_t)row * DM + col0;
#pragma unroll
                for (int bj = 0; bj < 2; ++bj)
#pragma unroll
                    for (int n = 0; n < 2; ++n) { const pg8::f32x4 xv = *(const pg8::f32x4*)(xr + bj * 128 + n * 16);
                        *(pg8::f32x4*)(orow + bj * 128 + n * 16) = xv + gv[bj][n] * acc[ai][bj][m][n]; } }
    }
};

__device__ __forceinline__ void phase0(const Params& p, unsigned char* lds) {
    int tid_o = threadIdx.x; asm volatile("" : "+v"(tid_o)); const int tid = tid_o, wid = tid >> 6, lane = tid & 63, G = gridDim.x, bid = blockIdx.x;
    if (bid == 0 && tid < 8) ((unsigned*)(p.ws + WS_CTR))[tid] = 0u;
    float* mod = (float*)(p.ws + WS_MOD);
    for (int item = bid; item < 192; item += G) {
        float* sil = (float*)lds;
        float* red = (float*)(lds + 40960);
        for (int i = tid; i < 5 * 2048; i += 512) { const int cn = i >> 11, k = i & 2047; const float v = cn == 0 ? p.c_ctx[k] : p.c[(cn - 1) * 2048 + k]; sil[i] = silu_f(v); }
        __syncthreads();
        const int col0 = item * 32 + (lane & 7) * 4, rsub = lane >> 3;
        float a0[4] = {0.f, 0.f, 0.f, 0.f}, a1[4] = {0.f, 0.f, 0.f, 0.f}, a2[4] = {0.f, 0.f, 0.f, 0.f}, a3[4] = {0.f, 0.f, 0.f, 0.f}, a4[4] = {0.f, 0.f, 0.f, 0.f};
        const float* wp = p.w_ada + (size_t)(wid * 256 + rsub) * 6144 + col0;
#pragma unroll 8
        for (int it = 0; it < 32; ++it) {
            const f32x4 w = *(const f32x4*)(wp + (size_t)it * 8 * 6144);
            const int k = wid * 256 + it * 8 + rsub;
            const float s0 = sil[k], s1 = sil[2048 + k], s2 = sil[4096 + k], s3 = sil[6144 + k], s4 = sil[8192 + k];
#pragma unroll
            for (int j = 0; j < 4; ++j) { a0[j] += s0 * w[j]; a1[j] += s1 * w[j]; a2[j] += s2 * w[j]; a3[j] += s3 * w[j]; a4[j] += s4 * w[j]; }
        }
#pragma unroll
        for (int j = 0; j < 4; ++j) {
            a0[j] += __shfl_xor(a0[j], 8); a0[j] += __shfl_xor(a0[j], 16); a0[j] += __shfl_xor(a0[j], 32);
            a1[j] += __shfl_xor(a1[j], 8); a1[j] += __shfl_xor(a1[j], 16); a1[j] += __shfl_xor(a1[j], 32);
            a2[j] += __shfl_xor(a2[j], 8); a2[j] += __shfl_xor(a2[j], 16); a2[j] += __shfl_xor(a2[j], 32);
            a3[j] += __shfl_xor(a3[j], 8); a3[j] += __shfl_xor(a3[j], 16); a3[j] += __shfl_xor(a3[j], 32);
            a4[j] += __shfl_xor(a4[j], 8); a4[j] += __shfl_xor(a4[j], 16); a4[j] += __shfl_xor(a4[j], 32);
        }
        if (lane < 8) {
#pragma unroll
            for (int j = 0; j < 4; ++j) { red[(wid * 5 + 0) * 32 + lane * 4 + j] = a0[j]; red[(wid * 5 + 1) * 32 + lane * 4 + j] = a1[j]; red[(wid * 5 + 2) * 32 + lane * 4 + j] = a2[j];
                red[(wid * 5 + 3) * 32 + lane * 4 + j] = a3[j]; red[(wid * 5 + 4) * 32 + lane * 4 + j] = a4[j]; }
        }
        __syncthreads();
        if (tid < 160) { const int cn = tid >> 5, col = tid & 31; float s = 0.f;
#pragma unroll
            for (int w = 0; w < 8; ++w) s += red[(w * 5 + cn) * 32 + col];
            const int gc = item * 32 + col; mod[cn * 6144 + gc] = s + p.b_ada[gc]; }
        __syncthreads();
    }
    {
        float* tl = (float*)(lds + 49152);
        constexpr int NT_IN = 32 * 104, NT_ALL = NT_IN + 32 * 32;
        for (int t = bid; t < NT_ALL; t += G) {
            const float* src; bf16_t* dst; int N, kt, ntl;
            if (t < NT_IN) { src = p.w_in; dst = (bf16_t*)(p.ws + WS_WIN); N = DIN; kt = t / 104; ntl = t - kt * 104; }
            else { const int t2 = t - NT_IN; src = p.w_out; dst = (bf16_t*)(p.ws + WS_WOUT); N = DM; kt = t2 >> 5; ntl = t2 & 31; }
            const int rk = tid >> 4, c4 = (tid & 15) * 4;
#pragma unroll
            for (int ps = 0; ps < 2; ++ps) { const int k = rk + ps * 32; const f32x4 v = *(const f32x4*)(src + (size_t)(kt * 64 + k) * N + ntl * 64 + c4);
                tl[k * 65 + c4 + 0] = v[0]; tl[k * 65 + c4 + 1] = v[1]; tl[k * 65 + c4 + 2] = v[2]; tl[k * 65 + c4 + 3] = v[3]; }
            __syncthreads();
            const int n = tid >> 3, k8 = (tid & 7) * 8;
            u32x4 w; w.x = cvtpk(tl[(k8 + 0) * 65 + n], tl[(k8 + 1) * 65 + n]); w.y = cvtpk(tl[(k8 + 2) * 65 + n], tl[(k8 + 3) * 65 + n]);
            w.z = cvtpk(tl[(k8 + 4) * 65 + n], tl[(k8 + 5) * 65 + n]); w.w = cvtpk(tl[(k8 + 6) * 65 + n], tl[(k8 + 7) * 65 + n]);
            const int nrow = (t < NT_IN) ? phys_col(ntl * 64 + n) : (ntl * 64 + n);
            *(u32x4*)(dst + (size_t)nrow * 2048 + kt * 64 + k8) = w;
            __syncthreads();
        }
    }
    {
        constexpr int C1 = 262144, C2 = 524288, C3 = 589824, C4 = 655360;
        for (int i = bid * 512 + tid; i < C4; i += G * 512) {
            const float* src; bf16_t* dst; int j, Wd;
            if (i < C1) { src = p.cdk; dst = (bf16_t*)(p.ws + WS_KA); j = i; Wd = 1024; }
            else if (i < C2) { src = p.cdv; dst = (bf16_t*)(p.ws + WS_VA); j = i - C1; Wd = 1024; }
            else if (i < C3) { src = p.cgk; dst = (bf16_t*)(p.ws + WS_KB); j = i - C2; Wd = 256; }
            else { src = p.cgv; dst = (bf16_t*)(p.ws + WS_VB); j = i - C3; Wd = 256; }
            const int e = j * 8; const int per_b = 512 * Wd; const int b = e / per_b, rem = e - b * per_b, s = rem / Wd, col = rem - s * Wd;
            const f32x4 v0 = *(const f32x4*)(src + e), v1 = *(const f32x4*)(src + e + 4);
            u32x4 w; w.x = cvtpk(v0[0], v0[1]); w.y = cvtpk(v0[2], v0[3]); w.z = cvtpk(v1[0], v1[1]); w.w = cvtpk(v1[2], v1[3]);
            *(u32x4*)(dst + ((size_t)(b * LKV + 1024 + s)) * Wd + col) = w;
        }
    }
}

__device__ __forceinline__ void phase1(const Params& p) {
    int tid_o = threadIdx.x; asm volatile("" : "+v"(tid_o)); const int tid = tid_o, wid = tid >> 6, lane = tid & 63, G = gridDim.x, bid = blockIdx.x;
    const float* mod = (const float*)(p.ws + WS_MOD);
    bf16_t* h = (bf16_t*)p.out;
    for (int row = bid * 8 + wid; row < MTOK; row += G * 8) {
        const float* xr = row < NCTX ? p.x_prompt + (size_t)row * DM : p.x_sample + (size_t)(row - NCTX) * DM;
        const int cn = row < NCTX ? 0 : 1 + ((row - NCTX) >> 10);
        f32x4 v[8]; float ss = 0.f;
#pragma unroll
        for (int i = 0; i < 8; ++i) { v[i] = *(const f32x4*)(xr + i * 256 + lane * 4); ss += v[i][0] * v[i][0] + v[i][1] * v[i][1] + v[i][2] * v[i][2] + v[i][3] * v[i][3]; }
        ss = wave_sum(ss);
        const float rstd = rsqrtf(ss * (1.0f / DM) + EPS);
        const float* sh = mod + cn * 6144; const float* sc = sh + 2048;
#pragma unroll
        for (int i = 0; i < 8; ++i) { const int col = i * 256 + lane * 4;
            const f32x4 g = *(const f32x4*)(p.g_norm + col), s1 = *(const f32x4*)(sc + col), s0 = *(const f32x4*)(sh + col);
            const f32x4 y = (v[i] * rstd) * g * (s1 + 1.0f) + s0;
            u32x2 w; w.x = cvtpk(y[0], y[1]); w.y = cvtpk(y[2], y[3]);
            *(u32x2*)(h + (size_t)row * DM + col) = w; }
    }
}

__device__ __forceinline__ void phase2b(const Params& p) {
    int tid_o = threadIdx.x; asm volatile("" : "+v"(tid_o)); const int tid = tid_o, wid = tid >> 6, lane = tid & 63, G = gridDim.x, bid = blockIdx.x;
    bf16_t* z = (bf16_t*)(p.ws + WS_Z);
    const float qg0 = p.qng[lane * 2], qg1 = p.qng[lane * 2 + 1], kg0 = p.kng[lane * 2], kg1 = p.kng[lane * 2 + 1];
    const float L2T = 13.287712379549449f;
    for (int row = bid * 8 + wid; row < MTOK; row += G * 8) {
        bf16_t* zr = z + (size_t)row * DIN;
        if (row < NCTX) {
#pragma unroll
            for (int i = 0; i < 2; ++i) { const int col = i * 512 + lane * 8;
                const u32x4 a = *(const u32x4*)(zr + ZKA + col); float* o = p.out + OUT_NDK + (size_t)row * 1024 + col;
                *(f32x4*)o = (f32x4){bf_lo(a.x), bf_hi(a.x), bf_lo(a.y), bf_hi(a.y)}; *(f32x4*)(o + 4) = (f32x4){bf_lo(a.z), bf_hi(a.z), bf_lo(a.w), bf_hi(a.w)};
                const u32x4 b = *(const u32x4*)(zr + ZVA + col); float* o2 = p.out + OUT_NDV + (size_t)row * 1024 + col;
                *(f32x4*)o2 = (f32x4){bf_lo(b.x), bf_hi(b.x), bf_lo(b.y), bf_hi(b.y)}; *(f32x4*)(o2 + 4) = (f32x4){bf_lo(b.z), bf_hi(b.z), bf_lo(b.w), bf_hi(b.w)}; }
            { const u32x2 a = *(const u32x2*)(zr + ZVB + lane * 4);
              *(f32x4*)(p.out + OUT_NGV + (size_t)row * 256 + lane * 4) = (f32x4){bf_lo(a.x), bf_hi(a.x), bf_lo(a.y), bf_hi(a.y)}; }
#pragma unroll
            for (int hd = 0; hd < 10; ++hd) { const int base = hd < 8 ? ZQB + hd * 128 : ZKB + (hd - 8) * 128;
                const unsigned w = *(const unsigned*)(zr + base + lane * 2); float a = bf_lo(w), b = bf_hi(w);
                const float ss = wave_sum(a * a + b * b); const float r = rsqrtf(ss * (1.0f / 128.0f) + EPS);
                a = a * r * (hd < 8 ? qg0 : kg0); b = b * r * (hd < 8 ? qg1 : kg1);
                *(unsigned*)(zr + base + lane * 2) = cvtpk(a, b);
                if (hd >= 8) { float* o = p.out + OUT_NGK + (size_t)row * 256 + (hd - 8) * 128 + lane * 2; o[0] = a; o[1] = b; } }
        } else {
            const int lr = row - NCTX, b = lr >> 10, pos = lr & 1023; const float prow = (float)(pos >> 6), pcol = (float)(pos & 63);
            const size_t krow = (size_t)(b * LKV + pos);
            float cA0, sA0, cA1, sA1; const bool firstA = (lane & 16) == 0;
            { const int f = (lane * 2) & 31;
              const float a0 = (f < 16 ? prow : pcol) * exp2f(-(float)(f & 15) * (L2T / 16.0f)), a1 = ((f + 1) < 16 ? prow : pcol) * exp2f(-(float)((f + 1) & 15) * (L2T / 16.0f));
              sincos_rev(a0, sA0, cA0); sincos_rev(a1, sA1, cA1); }
#pragma unroll 4
            for (int ch = 0; ch < 16; ++ch) { const int base = (ch < 8 ? ZQA : ZKA) + (ch & 7) * 128;
                const unsigned w = *(const unsigned*)(zr + base + lane * 2); const float a = bf_lo(w), bb = bf_hi(w);
                const float pa = __shfl_xor(a, 16), pb = __shfl_xor(bb, 16);
                const float o0 = firstA ? a * cA0 - pa * sA0 : pa * sA0 + a * cA0, o1 = firstA ? bb * cA1 - pb * sA1 : pb * sA1 + bb * cA1;
                if (ch < 8) *(unsigned*)(zr + base + lane * 2) = cvtpk(o0, o1);
                else *(unsigned*)((bf16_t*)(p.ws + WS_KA) + krow * 1024 + (ch & 7) * 128 + lane * 2) = cvtpk(o0, o1); }
#pragma unroll
            for (int i = 0; i < 2; ++i) { const int col = i * 512 + lane * 8; *(u32x4*)((bf16_t*)(p.ws + WS_VA) + krow * 1024 + col) = *(const u32x4*)(zr + ZVA + col); }
            *(u32x2*)((bf16_t*)(p.ws + WS_VB) + krow * 256 + lane * 4) = *(const u32x2*)(zr + ZVB + lane * 4);
            float cB0, sB0, cB1, sB1; const bool firstB = lane < 32;
            { const int f = (lane * 2) & 63;
              const float a0 = (f < 32 ? prow : pcol) * exp2f(-(float)(f & 31) * (L2T / 32.0f)), a1 = ((f + 1) < 32 ? prow : pcol) * exp2f(-(float)((f + 1) & 31) * (L2T / 32.0f));
              sincos_rev(a0, sB0, cB0); sincos_rev(a1, sB1, cB1); }
#pragma unroll 2
            for (int hd = 0; hd < 10; ++hd) { const int base = hd < 8 ? ZQB + hd * 128 : ZKB + (hd - 8) * 128;
                const unsigned w = *(const unsigned*)(zr + base + lane * 2); float a = bf_lo(w), bb = bf_hi(w);
                const float ss = wave_sum(a * a + bb * bb); const float r = rsqrtf(ss * (1.0f / 128.0f) + EPS);
                a = a * r * (hd < 8 ? qg0 : kg0); bb = bb * r * (hd < 8 ? qg1 : kg1);
                const float pa = __shfl_xor(a, 32), pb = __shfl_xor(bb, 32);
                const float o0 = firstB ? a * cB0 - pa * sB0 : pa * sB0 + a * cB0, o1 = firstB ? bb * cB1 - pb * sB1 : pb * sB1 + bb * cB1;
                if (hd < 8) *(unsigned*)(zr + base + lane * 2) = cvtpk(o0, o1);
                else *(unsigned*)((bf16_t*)(p.ws + WS_KB) + krow * 256 + (hd - 8) * 128 + lane * 2) = cvtpk(o0, o1); }
        }
    }
}

namespace at {
constexpr int NW = 8, QBLK = 32, KVBLK = 64;
constexpr float THR = 8.f;
constexpr int SHM_V = 16384, SHM_K = 16384;
#define AT_SBAR() __builtin_amdgcn_sched_barrier(0)
template <int DK> __device__ __forceinline__ int kswz(int row, int colB) { return DK == 128 ? row * 256 + (colB ^ ((row & 7) << 4)) : row * 128 + (colB ^ (((row >> 1) & 7) << 4)); }
__device__ __forceinline__ int crow(int r, int hi) { return (r & 3) + 8 * (r >> 2) + 4 * hi; }

template <int DK> __device__ __forceinline__ void partialSM(f32x16& p0, f32x16& p1, float& m_reg, float& mn, float& alpha) {
    constexpr float SCALE = DK == 128 ? 0.088388347648318440f : 0.125f;
    constexpr float C = SCALE * 1.4426950408889634f;
    float pmax = p0[0];
#pragma unroll
    for (int r = 1; r < 16; ++r) pmax = fmaxf(pmax, p0[r]);
#pragma unroll
    for (int r = 0; r < 16; ++r) pmax = fmaxf(pmax, p1[r]);
    { auto rr = __builtin_amdgcn_permlane32_swap(__float_as_uint(pmax), __float_as_uint(pmax), false, false);
      pmax = fmaxf(__uint_as_float(rr[0]), __uint_as_float(rr[1])); }
    if (__builtin_expect(__all(pmax - m_reg <= THR / SCALE), 1)) { mn = m_reg; alpha = 1.f; }
    else { mn = fmaxf(m_reg, pmax); alpha = __builtin_amdgcn_exp2f((m_reg - mn) * C); m_reg = mn; }
    const float mnC = -mn * C;
#pragma unroll
    for (int r = 0; r < 16; ++r) p0[r] = fmaf(p0[r], C, mnC);
#pragma unroll
    for (int r = 0; r < 16; ++r) p1[r] = fmaf(p1[r], C, mnC);
#pragma unroll
    for (int r = 0; r < 16; ++r) p0[r] = __builtin_amdgcn_exp2f(p0[r]);
}
__device__ __forceinline__ void finishSM(f32x16& p0, f32x16& p1, float alpha, float& l_reg, bf16x8& pa0, bf16x8& pa1, bf16x8& pa2, bf16x8& pa3) {
#pragma unroll
    for (int r = 0; r < 16; ++r) p1[r] = __builtin_amdgcn_exp2f(p1[r]);
    float ps = 0;
#pragma unroll
    for (int r = 0; r < 16; ++r) ps += p0[r];
#pragma unroll
    for (int r = 0; r < 16; ++r) ps += p1[r];
    { auto rr = __builtin_amdgcn_permlane32_swap(__float_as_uint(ps), __float_as_uint(ps), false, false);
      ps = __uint_as_float(rr[0]) + __uint_as_float(rr[1]); }
    l_reg = l_reg * alpha + ps;
#define AT_PK4(P, BASE, OUT) do { unsigned a0 = cvtpk(P[BASE + 0], P[BASE + 1]), a1 = cvtpk(P[BASE + 2], P[BASE + 3]);   \
    unsigned b0 = cvtpk(P[BASE + 4], P[BASE + 5]), b1 = cvtpk(P[BASE + 6], P[BASE + 7]);                              \
    auto r0 = __builtin_amdgcn_permlane32_swap(a0, b0, false, false); auto r1 = __builtin_amdgcn_permlane32_swap(a1, b1, false, false); \
    u32x4 w = {r0[0], r1[0], r0[1], r1[1]}; OUT = *reinterpret_cast<bf16x8*>(&w); } while (0)
    AT_PK4(p0, 0, pa0); AT_PK4(p0, 8, pa1); AT_PK4(p1, 0, pa2); AT_PK4(p1, 8, pa3);
#undef AT_PK4
}
template <int DK> __device__ __forceinline__ void qkt(f32x16& p0, f32x16& p1, const char* Ks, const bf16x8* qr, int r32, int hi) {
    p0 = f32x16{}; p1 = f32x16{};
#pragma unroll
    for (int d0 = 0; d0 < DK / 16; ++d0) { const int cb = (d0 * 16 + hi * 8) * 2;
        const bf16x8 b0 = *reinterpret_cast<const bf16x8*>(Ks + kswz<DK>(r32, cb));
        const bf16x8 b1 = *reinterpret_cast<const bf16x8*>(Ks + kswz<DK>(32 + r32, cb));
        p0 = __builtin_amdgcn_mfma_f32_32x32x16_bf16(b0, qr[d0], p0, 0, 0, 0);
        p1 = __builtin_amdgcn_mfma_f32_32x32x16_bf16(b1, qr[d0], p1, 0, 0, 0); }
}
__device__ __forceinline__ int v_st(int k, int c) { const int kk = (k & ~0xC) | ((k & 4) << 1) | ((k & 8) >> 1); return ((kk >> 3) * 4 + (c >> 5)) * 512 + ((kk & 7) * 32 + (c & 31)) * 2; }
__device__ __forceinline__ int v_rd_base(int lane) { return ((lane & 3) << 3) | (((lane >> 2) & 3) << 6) | (((lane >> 4) & 1) << 5) | (((lane >> 5) & 1) << 8); }
constexpr int v_rd_off(int d0, int ks, int half) { return d0 * 512 + ks * 4096 + half * 2048; }
template <int OFF> __device__ __forceinline__ s16x4 tr_read(int vb) {
    s16x4 r; asm volatile("ds_read_b64_tr_b16 %0, %1 offset:%2" : "=&v"(r) : "v"(vb), "i"(OFF) : "memory"); return r;
}
template <int D0> __device__ __forceinline__ void pv_one(f32x16& od, int vb, bf16x8 pa0, bf16x8 pa1, bf16x8 pa2, bf16x8 pa3) {
    const s16x4 l0 = tr_read<v_rd_off(D0, 0, 0)>(vb), h0 = tr_read<v_rd_off(D0, 0, 1)>(vb), l1 = tr_read<v_rd_off(D0, 1, 0)>(vb), h1 = tr_read<v_rd_off(D0, 1, 1)>(vb);
    const s16x4 l2 = tr_read<v_rd_off(D0, 2, 0)>(vb), h2 = tr_read<v_rd_off(D0, 2, 1)>(vb), l3 = tr_read<v_rd_off(D0, 3, 0)>(vb), h3 = tr_read<v_rd_off(D0, 3, 1)>(vb);
    asm volatile("s_waitcnt lgkmcnt(0)" ::: "memory"); AT_SBAR();
#define AT_PK(L, H) (bf16x8){L[0], L[1], L[2], L[3], H[0], H[1], H[2], H[3]}
    od = __builtin_amdgcn_mfma_f32_32x32x16_bf16(pa0, AT_PK(l0, h0), od, 0, 0, 0);
    od = __builtin_amdgcn_mfma_f32_32x32x16_bf16(pa1, AT_PK(l1, h1), od, 0, 0, 0);
    od = __builtin_amdgcn_mfma_f32_32x32x16_bf16(pa2, AT_PK(l2, h2), od, 0, 0, 0);
    od = __builtin_amdgcn_mfma_f32_32x32x16_bf16(pa3, AT_PK(l3, h3), od, 0, 0, 0);
#undef AT_PK
}
__device__ __forceinline__ void pv_d0(f32x16* o, int vb, bf16x8 pa0, bf16x8 pa1, bf16x8 pa2, bf16x8 pa3) {
    pv_one<0>(o[0], vb, pa0, pa1, pa2, pa3); pv_one<1>(o[1], vb, pa0, pa1, pa2, pa3); pv_one<2>(o[2], vb, pa0, pa1, pa2, pa3); pv_one<3>(o[3], vb, pa0, pa1, pa2, pa3);
}

template <int DK>
__device__ __forceinline__ void attn_pass(const bf16_t* Qb, int ldq, const bf16_t* Kh, int ldk, const bf16_t* Vh, int ldv, int seq, char* lds, f32x16 (&o)[4]) {
    int tid_o = threadIdx.x; asm volatile("" : "+v"(tid_o)); const int tid = tid_o, wid = tid >> 6, lane = tid & 63, r32 = lane & 31, hi = lane >> 5;
    char* V_lds = lds; char* K_lds = lds + 2 * SHM_V;
    float* wsf = (float*)(lds + 2 * SHM_V + 2 * SHM_K) + wid * 64; float* li_l = wsf; float* al_l = wsf + 32;
    float m_reg = -1e30f, l_reg = 0;
#pragma unroll
    for (int d = 0; d < 4; ++d) o[d] = f32x16{};
    bf16x8 qr[DK / 16];
    const bf16_t* Qw = Qb + (size_t)(wid * QBLK + r32) * ldq + hi * 8;
#pragma unroll
    for (int d0 = 0; d0 < DK / 16; ++d0) qr[d0] = *reinterpret_cast<const bf16x8*>(Qw + d0 * 16);
    const int sr = tid >> 4, sc = (tid & 15) * 8, vst0 = v_st(sr, sc), vst1 = v_st(32 + sr, sc);
    const int kr64 = tid >> 3, kc64 = (tid & 7) * 8;
    const int vb0 = (int)(uintptr_t)V_lds + v_rd_base(lane);
    struct { bf16x8 vs0, vs1, ks0, ks1; } sr_[2];
#define AT_SLOAD(i, k0) do { sr_[i].vs0 = *reinterpret_cast<const bf16x8*>(&Vh[(size_t)((k0) + sr) * ldv + sc]); sr_[i].vs1 = *reinterpret_cast<const bf16x8*>(&Vh[(size_t)((k0) + 32 + sr) * ldv + sc]); \
    if constexpr (DK == 128) { sr_[i].ks0 = *reinterpret_cast<const bf16x8*>(&Kh[(size_t)((k0) + sr) * ldk + sc]); sr_[i].ks1 = *reinterpret_cast<const bf16x8*>(&Kh[(size_t)((k0) + 32 + sr) * ldk + sc]); } \
    else { sr_[i].ks0 = *reinterpret_cast<const bf16x8*>(&Kh[(size_t)((k0) + kr64) * ldk + kc64]); } } while (0)
#define AT_SWRITE(b, i) do { *(bf16x8*)(V_lds + (b) * SHM_V + vst0) = sr_[i].vs0; *(bf16x8*)(V_lds + (b) * SHM_V + vst1) = sr_[i].vs1; \
    if constexpr (DK == 128) { *(bf16x8*)(K_lds + (b) * SHM_K + kswz<128>(sr, sc * 2)) = sr_[i].ks0; *(bf16x8*)(K_lds + (b) * SHM_K + kswz<128>(32 + sr, sc * 2)) = sr_[i].ks1; } \
    else { *(bf16x8*)(K_lds + (b) * SHM_K + kswz<64>(kr64, kc64 * 2)) = sr_[i].ks0; } } while (0)
#define AT_SWAIT() do { if constexpr (DK == 128) asm volatile("s_waitcnt vmcnt(4)" ::: "memory"); else asm volatile("s_waitcnt vmcnt(3)" ::: "memory"); } while (0)
#define AT_RESC(a) do { if (__any((a) < 1.f)) { if (hi == 0) al_l[r32] = (a); asm volatile("s_waitcnt lgkmcnt(0)" ::: "memory"); \
    _Pragma("unroll") for (int d = 0; d < 4; ++d) _Pragma("unroll") for (int r = 0; r < 16; ++r) o[d][r] *= al_l[crow(r, hi)]; } } while (0)
    f32x16 pA0, pA1, pB0, pB1; float mnA, mnB, alA, alB; bf16x8 pa0, pa1, pa2, pa3; const int NT = seq / KVBLK;
    __syncthreads();
    AT_SLOAD(0, 0); asm volatile("s_waitcnt vmcnt(0)" ::: "memory"); AT_SWRITE(0, 0); __syncthreads();
    qkt<DK>(pA0, pA1, K_lds, qr, r32, hi); partialSM<DK>(pA0, pA1, m_reg, mnA, alA);
    AT_SLOAD(1, KVBLK); if (2 < NT) AT_SLOAD(0, 2 * KVBLK);
    AT_SWAIT(); AT_SWRITE(1, 1); __syncthreads();
    for (int j = 1; j + 1 < NT; j += 2) {
        AT_SBAR(); qkt<DK>(pB0, pB1, K_lds + SHM_K, qr, r32, hi);
        finishSM(pA0, pA1, alA, l_reg, pa0, pa1, pa2, pa3); AT_SBAR();
        AT_SLOAD(1, (j + 2) * KVBLK); AT_SBAR();
        pv_d0(o, vb0, pa0, pa1, pa2, pa3); partialSM<DK>(pB0, pB1, m_reg, mnB, alB);
        __syncthreads(); AT_SWAIT(); AT_SWRITE(0, 0);
        AT_RESC(alB); __syncthreads();
        AT_SBAR(); qkt<DK>(pA0, pA1, K_lds, qr, r32, hi);
        finishSM(pB0, pB1, alB, l_reg, pa0, pa1, pa2, pa3); AT_SBAR();
        if (j + 3 < NT) AT_SLOAD(0, (j + 3) * KVBLK); AT_SBAR();
        pv_d0(o, vb0 + SHM_V, pa0, pa1, pa2, pa3); partialSM<DK>(pA0, pA1, m_reg, mnA, alA);
        __syncthreads(); AT_SWAIT(); AT_SWRITE(1, 1);
        AT_RESC(alA); __syncthreads();
    }
    AT_SBAR(); qkt<DK>(pB0, pB1, K_lds + SHM_K, qr, r32, hi);
    finishSM(pA0, pA1, alA, l_reg, pa0, pa1, pa2, pa3); AT_SBAR();
    pv_d0(o, vb0, pa0, pa1, pa2, pa3); partialSM<DK>(pB0, pB1, m_reg, mnB, alB);
    __syncthreads(); AT_RESC(alB);
    finishSM(pB0, pB1, alB, l_reg, pa0, pa1, pa2, pa3); AT_SBAR();
    pv_d0(o, vb0 + SHM_V, pa0, pa1, pa2, pa3);
    if (hi == 0) li_l[r32] = l_reg; asm volatile("s_waitcnt lgkmcnt(0)" ::: "memory");
#pragma unroll
    for (int r = 0; r < 16; ++r) { const float rl = __builtin_amdgcn_rcpf(li_l[crow(r, hi)]);
#pragma unroll
        for (int d = 0; d < 4; ++d) o[d][r] *= rl; }
#undef AT_SLOAD
#undef AT_SWRITE
#undef AT_SWAIT
#undef AT_RESC
}
}

__device__ __forceinline__ void phase3(const Params& p, unsigned char* lds_u, int rep) {
    char* lds = (char*)lds_u;
    int tid_o = threadIdx.x; asm volatile("" : "+v"(tid_o)); const int tid = tid_o;
    int* s_unit = (int*)(lds + 67 * 1024);
    unsigned* ctr = (unsigned*)(p.ws + WS_CTR) + rep;
    const bf16_t* z = (const bf16_t*)(p.ws + WS_Z);
    bf16_t* ob = (bf16_t*)(p.ws + WS_O);
    float* scr = p.out + (size_t)blockIdx.x * 32768; const unsigned voff = (unsigned)tid * 16u;
    for (;;) {
        __syncthreads();
        if (tid == 0) *s_unit = (int)atomicAdd(ctr, 1u);
        __syncthreads();
        const int u = *s_unit;
        if (u >= 768) break;
        f32x16 o[4];
        if (u < 128 || (u >= 256 && u < 512)) {
            int b, h, row0, seq, ldk; const bf16_t *K, *V;
            if (u < 128) { b = u >> 5; h = (u >> 2) & 7; row0 = NCTX + b * 1024 + (u & 3) * 256; seq = LKV; ldk = 1024;
                K = (const bf16_t*)(p.ws + WS_KA) + (size_t)b * LKV * 1024 + h * 128; V = (const bf16_t*)(p.ws + WS_VA) + (size_t)b * LKV * 1024 + h * 128; }
            else { const int v = u - 256; b = v >> 3; h = v & 7; row0 = b * 256; seq = 256; ldk = DIN;
                K = z + (size_t)row0 * DIN + ZKA + h * 128; V = z + (size_t)row0 * DIN + ZVA + h * 128; }
            const bf16_t* Q = z + (size_t)row0 * DIN + ZQA + h * 128;
#pragma unroll 1
            for (int cmap = 0; cmap < 2; ++cmap) {
                at::attn_pass<64>(Q + cmap * 64, DIN, K + cmap * 64, ldk, V, ldk, seq, lds, o);
                if (cmap == 0) {
                    unsigned voff2 = voff; asm volatile("" : "+v"(voff2));
#pragma unroll
                    for (int d = 0; d < 4; ++d)
#pragma unroll
                        for (int q = 0; q < 4; ++q) *(f32x4*)((char*)scr + (d * 4 + q) * 8192 + voff2) = (f32x4){o[d][4 * q], o[d][4 * q + 1], o[d][4 * q + 2], o[d][4 * q + 3]};
                }
            }
            int tid2 = tid; asm volatile("" : "+v"(tid2));
            const int wid = tid2 >> 6, lane = tid2 & 63, r32 = lane & 31, hi = lane >> 5;
            float la = p.lq1[h * 64 + lane] * p.lk1[h * 64 + lane], lb = p.lq2[h * 64 + lane] * p.lk2[h * 64 + lane];
            la = wave_sum(la); lb = wave_sum(lb);
            const float lam = __expf(la) - __expf(lb) + 0.2f;
#pragma unroll
            for (int d = 0; d < 4; ++d)
#pragma unroll
                for (int q = 0; q < 4; ++q) { const f32x4 t = *(const f32x4*)((const char*)scr + (d * 4 + q) * 8192 + (unsigned)(tid2 * 16));
                    o[d][4 * q] = t[0] - lam * o[d][4 * q]; o[d][4 * q + 1] = t[1] - lam * o[d][4 * q + 1]; o[d][4 * q + 2] = t[2] - lam * o[d][4 * q + 2]; o[d][4 * q + 3] = t[3] - lam * o[d][4 * q + 3]; }
            float sg[4];
#pragma unroll
            for (int d = 0; d < 4; ++d) sg[d] = p.subln[d * 32 + r32] * 0.8f;
#pragma unroll
            for (int r = 0; r < 16; ++r) {
                float ss = o[0][r] * o[0][r] + o[1][r] * o[1][r] + o[2][r] * o[2][r] + o[3][r] * o[3][r];
                ss += __shfl_xor(ss, 16); ss += __shfl_xor(ss, 8); ss += __shfl_xor(ss, 4); ss += __shfl_xor(ss, 2); ss += __shfl_xor(ss, 1);
                const float rstd = rsqrtf(ss * (1.0f / 128.0f) + EPS);
                const int row = row0 + wid * 32 + at::crow(r, hi);
#pragma unroll
                for (int d = 0; d < 4; ++d) { const int col = h * 128 + d * 32 + r32;
                    const float g = bf2f(z[(size_t)row * DIN + ZGA + col]);
                    ob[(size_t)row * DM + col] = f2bf(o[d][r] * rstd * sg[d] * g); }
            }
        } else {
            int b, h, row0, seq, ldk; const bf16_t *K, *V;
            if (u < 256) { const int v = u - 128; b = v >> 5; h = (v >> 2) & 7; row0 = NCTX + b * 1024 + (v & 3) * 256; seq = LKV; ldk = 256;
                K = (const bf16_t*)(p.ws + WS_KB) + (size_t)b * LKV * 256 + (h >> 2) * 128; V = (const bf16_t*)(p.ws + WS_VB) + (size_t)b * LKV * 256 + (h >> 2) * 128; }
            else { const int v = u - 512; b = v >> 3; h = v & 7; row0 = b * 256; seq = 256; ldk = DIN;
                K = z + (size_t)row0 * DIN + ZKB + (h >> 2) * 128; V = z + (size_t)row0 * DIN + ZVB + (h >> 2) * 128; }
            const bf16_t* Q = z + (size_t)row0 * DIN + ZQB + h * 128;
            at::attn_pass<128>(Q, DIN, K, ldk, V, ldk, seq, lds, o);
            int tid2 = tid; asm volatile("" : "+v"(tid2));
            const int wid = tid2 >> 6, lane = tid2 & 63, r32 = lane & 31, hi = lane >> 5;
#pragma unroll
            for (int r = 0; r < 16; ++r) { const int row = row0 + wid * 32 + at::crow(r, hi);
#pragma unroll
                for (int d = 0; d < 4; ++d) { const int col = h * 128 + d * 32 + r32;
                    const float g = bf2f(z[(size_t)row * DIN + ZGB + col]);
                    ob[(size_t)row * DM + 1024 + col] = f2bf(o[d][r] * g); } }
        }
    }
}

template <bool DRY> __device__ __forceinline__ void phase5(const Params& p) {
    int tid_o = threadIdx.x; asm volatile("" : "+v"(tid_o)); const int tid = tid_o, wid = tid >> 6, lane = tid & 63, G = gridDim.x, bid = blockIdx.x;
    for (int row = bid * 8 + wid; row < MTOK; row += G * 8) {
        float* yr = p.out + (size_t)row * DM;
        f32x4 v[8]; float ss = 0.f;
#pragma unroll
        for (int i = 0; i < 8; ++i) { v[i] = *(const f32x4*)(yr + i * 256 + lane * 4); ss += v[i][0] * v[i][0] + v[i][1] * v[i][1] + v[i][2] * v[i][2] + v[i][3] * v[i][3]; }
        ss = wave_sum(ss);
        const float rstd = rsqrtf(ss * (1.0f / DM) + EPS);
#pragma unroll
        for (int i = 0; i < 8; ++i) { const int col = i * 256 + lane * 4; const f32x4 g = *(const f32x4*)(p.g_final + col); *(f32x4*)(yr + col) = DRY ? (v[i] + 0.f * rstd * g) : (v[i] * rstd) * g; }
    }
}

__global__ void __launch_bounds__(512, 2) mega_fwd(Params p) {
    extern __shared__ __attribute__((aligned(16))) unsigned char lds[];
    cg::grid_group grid = cg::this_grid();
    const int G = gridDim.x, c = blockIdx.x;
#ifndef REP_P0
#define REP_P0 1
#endif
#ifndef REP_P1
#define REP_P1 1
#endif
#ifndef REP_P2
#define REP_P2 1
#endif
#ifndef REP_P3
#define REP_P3 1
#endif
#ifndef REP_P4
#define REP_P4 1
#endif
#pragma unroll 1
    for (int rep = 0; rep < REP_P0; ++rep) { phase0(p, lds); grid.sync(); }
#pragma unroll 1
    for (int rep = 0; rep < REP_P1; ++rep) { phase1(p); grid.sync(); }
#pragma unroll 1
    for (int rep = 0; rep < REP_P2; ++rep) {
        pg8::Gemm g; g.A = (const bf16_t*)p.out; g.Bt = (const bf16_t*)(p.ws + WS_WIN); g.M = MTOK; g.N = DIN; g.K = DM;
        pg8::StaticOrder S; S.init(g.M, g.N, G, c);
        EpiFused E; E.z = (bf16_t*)(p.ws + WS_Z); E.KA = (bf16_t*)(p.ws + WS_KA); E.VA = (bf16_t*)(p.ws + WS_VA); E.KB = (bf16_t*)(p.ws + WS_KB); E.VB = (bf16_t*)(p.ws + WS_VB);
        E.out = p.out; E.qng = p.qng; E.kng = p.kng; E.P = (PG8_LAS float*)((PG8_LAS unsigned char*)lds + 131072);
        pg8::gemm_phase<EpiFused, pg8::StaticOrder, false>((PG8_LAS unsigned char*)lds, g, S, E, nullptr);
        grid.sync();
    }
#pragma unroll 1
    for (int rep = 0; rep < REP_P3; ++rep) { phase3(p, lds, rep); grid.sync(); }
#pragma unroll 1
    for (int rep = 0; rep < REP_P4; ++rep) {
        pg8::Gemm g; g.A = (const bf16_t*)(p.ws + WS_O); g.Bt = (const bf16_t*)(p.ws + WS_WOUT); g.M = MTOK; g.N = DM; g.K = DM;
        pg8::StaticOrder S; S.init(g.M, g.N, G, c);
        EpiRes E; E.xp = p.x_prompt; E.xs = p.x_sample; E.mod = (const float*)(p.ws + WS_MOD); E.out = p.out;
        pg8::gemm_phase<EpiRes, pg8::StaticOrder, false>((PG8_LAS unsigned char*)lds, g, S, E, nullptr);
        grid.sync();
    }
#ifdef PROBE_P5
    phase5<true>(p); grid.sync();
#endif
    phase5<false>(p);
}

extern "C" void kernel_launch(void* const* d_in, const int* in_sizes, int n_in, void* d_out, int out_size, void* d_ws, size_t ws_size, hipStream_t stream) {
    static int grid_blocks = 0;
    if (grid_blocks == 0) {
        if (n_in != 21 || ws_size < WS_END) { fprintf(stderr, "kernel_launch: unexpected n_in %d / ws %zu\n", n_in, ws_size); grid_blocks = -1; return; }
        int dev = 0, cus = 0, per_cu = 0;
        hipGetDevice(&dev);
        hipDeviceGetAttribute(&cus, hipDeviceAttributeMultiprocessorCount, dev);
        if (hipFuncSetAttribute((const void*)mega_fwd, hipFuncAttributeMaxDynamicSharedMemorySize, LDS_BYTES) != hipSuccess) { fprintf(stderr, "kernel_launch: hipFuncSetAttribute failed\n"); grid_blocks = -1; return; }
        if (hipOccupancyMaxActiveBlocksPerMultiprocessor(&per_cu, (const void*)mega_fwd, 512, LDS_BYTES) != hipSuccess || per_cu < 1) { fprintf(stderr, "kernel_launch: occupancy query failed (%d)\n", per_cu); grid_blocks = -1; return; }
        grid_blocks = cus * per_cu;
        if (grid_blocks > 256) grid_blocks = 256;
    }
    if (grid_blocks < 0) return;
    Params p{};
    p.x_prompt = (const float*)d_in[0]; p.x_sample = (const float*)d_in[1]; p.cdk = (const float*)d_in[2]; p.cdv = (const float*)d_in[3]; p.cgk = (const float*)d_in[4]; p.cgv = (const float*)d_in[5];
    p.c = (const float*)d_in[6]; p.c_ctx = (const float*)d_in[7]; p.w_ada = (const float*)d_in[8]; p.b_ada = (const float*)d_in[9]; p.g_norm = (const float*)d_in[10]; p.w_in = (const float*)d_in[11];
    p.lq1 = (const float*)d_in[12]; p.lk1 = (const float*)d_in[13]; p.lq2 = (const float*)d_in[14]; p.lk2 = (const float*)d_in[15]; p.subln = (const float*)d_in[16]; p.qng = (const float*)d_in[17];
    p.kng = (const float*)d_in[18]; p.w_out = (const float*)d_in[19]; p.g_final = (const float*)d_in[20];
    p.out = (float*)d_out; p.ws = (unsigned char*)d_ws;
    void* args[] = {&p};
    hipError_t e = hipLaunchCooperativeKernel((const void*)mega_fwd, dim3(grid_blocks), dim3(512), args, LDS_BYTES, stream);
    if (e != hipSuccess) fprintf(stderr, "cooperative launch failed: %s (grid %d)\n", hipGetErrorString(e), grid_blocks);
}
```

```cpp
#include <hip/hip_runtime.h>
#include <hip/hip_cooperative_groups.h>
#include <cstdio>
#include <cstdint>
namespace cg = cooperative_groups;
namespace pg8 {
#define PG8_LAS __attribute__((address_space(3)))
typedef unsigned short bf16_t;
typedef short bf16x8 __attribute__((ext_vector_type(8)));
typedef float f32x4 __attribute__((ext_vector_type(4)));
typedef unsigned u32x4 __attribute__((ext_vector_type(4)));
constexpr int BM = 256, BK = 64, HALF = 128, HTB = HALF * BK * 2  , STAGE_BYTES = 8 * HTB, NXCD = 8, WGM = 8;

__host__ __device__ __forceinline__ int lds_byte(int r, int c) { const int st = (r >> 4) * 2 + (c >> 5), rr = r & 15, cc = c & 31, ob = rr * 64 + cc * 2; return st * 1024 + (ob ^ (((ob >> 9) & 1) << 5)); }
__host__ __device__ __forceinline__ void stage_rc(int b, int& R, int& C) { const int st = b / 1024, sb = b % 1024, swz = sb ^ (((sb >> 9) & 1) << 5); R = (st >> 1) * 16 + swz / 64; C = (st & 1) * 32 + (swz % 64) / 2; }
__host__ __device__ __forceinline__ int perm32(int rho) { const int n = rho >> 4, i = rho & 15; return 8 * (i >> 2) + 4 * n + (i & 3); }

struct Unit { int pm, pn; };
struct Gemm { const bf16_t* A; const bf16_t* Bt; int M, N, K; };

struct StaticOrder {
    int nM, nN, nwg, G, c;
    __host__ __device__ void init(int M, int N, int G_, int c_) { nM = M / BM; nN = N / BM; nwg = nM * nN; G = G_; c = c_; }
    __host__ __device__ bool next(int i, Unit& u) const {
        const long L = (long)i * G + c; if (L >= nwg) return false;
        int wgid = (int)L; { const int q = nwg / NXCD, r = nwg % NXCD, xcd = wgid % NXCD, off = wgid / NXCD; wgid = (xcd < r ? xcd * (q + 1) : r * (q + 1) + (xcd - r) * q) + off; }
        const int nig = WGM * nN, gid = wgid / nig, fm = gid * WGM, gsz = (nM - fm) < WGM ? (nM - fm) : WGM;
        u.pm = fm + ((wgid % nig) % gsz); u.pn = (wgid % nig) / gsz; return true;
    }
    __device__ __forceinline__ void a_ready(const Unit&) const {}
    __device__ __forceinline__ void done(const Unit&) const {}
};
struct CountedOrder : StaticOrder {
    const unsigned* ready; unsigned need; unsigned* tmo;
    __device__ __forceinline__ void a_ready(const Unit& u) const {
        if (threadIdx.x < 64) {
            const unsigned long long t0 = __builtin_amdgcn_s_memrealtime(); unsigned polls = 0;
            while ((unsigned)__builtin_amdgcn_readfirstlane(__hip_atomic_load(ready + 64 * u.pm, __ATOMIC_RELAXED, __HIP_MEMORY_SCOPE_AGENT)) < need) {
                if ((++polls & 255u) == 0u && __builtin_amdgcn_readfirstlane(__hip_atomic_load(tmo, __ATOMIC_RELAXED, __HIP_MEMORY_SCOPE_AGENT)) != 0u) break;
                if (__builtin_amdgcn_s_memrealtime() - t0 > 2000000ull) {
                    if (threadIdx.x == 0) { unsigned expect = 0u; __hip_atomic_compare_exchange_strong(tmo + 1, &expect, 0x600u | (unsigned)(u.pm & 0xff), __ATOMIC_RELAXED, __ATOMIC_RELAXED, __HIP_MEMORY_SCOPE_AGENT); __hip_atomic_store(tmo, 1u, __ATOMIC_RELAXED, __HIP_MEMORY_SCOPE_AGENT); }
                    break; }
                __builtin_amdgcn_s_sleep(2); }
            __builtin_amdgcn_fence(__ATOMIC_ACQUIRE, "agent");
            asm volatile("s_waitcnt vmcnt(0)" ::: "memory");
        }
#if !defined(BROKEN_HOOK_NO_BARRIER)
        asm volatile("" ::: "memory"); __builtin_amdgcn_s_barrier(); asm volatile("" ::: "memory");
#endif
    }
};

__device__ __forceinline__ unsigned cvt_pk_bf16(float lo, float hi) { unsigned r; asm volatile("v_cvt_pk_bf16_f32 %0, %1, %2" : "=v"(r) : "v"(lo), "v"(hi)); return r; }
typedef float f32x2 __attribute__((ext_vector_type(2)));
__device__ __forceinline__ f32x2 gelu_pk(f32x2 v) {
    const f32x2 av = __builtin_elementwise_abs(v), d = av * 0.2316418882f + 1.0f;
    f32x2 t; t.x = __builtin_amdgcn_rcpf(d.x); t.y = __builtin_amdgcn_rcpf(d.y);
    f32x2 q = t * 0.5307027145f + (-0.7265760135f); q = q * t + 0.7107068705f; q = q * t + (-0.142248368f); q = q * t + 0.127414796f; q = q * t;
    const f32x2 s = (v * v) * (-0.72134752044f);
    f32x2 e; e.x = __builtin_amdgcn_exp2f(s.x); e.y = __builtin_amdgcn_exp2f(s.y);
    const f32x2 m = v * (q * e), r = v - m;
    f32x2 o; o.x = v.x < 0.f ? m.x : r.x; o.y = v.y < 0.f ? m.y : r.y; return o;
}

template <class Epi, class Sched, bool STAMP = false>
__device__ __forceinline__ void gemm_phase(PG8_LAS unsigned char* lds, const Gemm g, const Sched& S, const Epi& E, unsigned long long* stamps) {
    int tid_o = threadIdx.x; asm volatile("" : "+v"(tid_o)); const int tid = tid_o, wid = __builtin_amdgcn_readfirstlane(tid >> 6), lane = tid & 63, wr = wid >> 2, wc = wid & 3, fr = lane & 15, fq = lane >> 4;
    const int K = g.K, nt = K / BK;
    int ts_lo = 0, ts_hi = 0, nts = 0; const unsigned long long rt_entry = STAMP ? (unsigned long long)wall_clock64() : 0ull;
#define PG8_STAMP() do { if (STAMP && wid == 0 && nts < 64) { const unsigned long long _c = (unsigned long long)clock64(); \
        ts_lo = (lane == nts) ? (int)(unsigned)_c : ts_lo; ts_hi = (lane == nts) ? (int)(unsigned)(_c >> 32) : ts_hi; ++nts; } } while (0)
    PG8_STAMP();
    unsigned voffA[2], voffB[2];
#pragma unroll
    for (int i = 0; i < 2; ++i) { int R, C; stage_rc(tid * 16 + i * 8192, R, C); const int Rb = Epi::PERM ? ((R & ~31) + perm32(R & 31)) : R;
        voffA[i] = (unsigned)(R * K + C) * 2u; voffB[i] = (unsigned)(Rb * K + C) * 2u; }
    const size_t kstep = (size_t)(BK * 2);
    const size_t hstep = (size_t)HALF * K * 2;
    const size_t tstep = 2 * hstep;
    const unsigned ldsw = (unsigned)wid * 1024u;
    const int aoff = lds_byte(wr * 64 + fr, fq * 8), boff = lds_byte(wc * 32 + fr, fq * 8);
#define PG8_SA(b, h) (((b) * 2 + (h)) * HTB)
#define PG8_SB(b, h) ((4 + (b) * 2 + (h)) * HTB)
#define PG8_STAGE(bufoff, gbase, voff) do { _Pragma("unroll") for (int _i = 0; _i < 2; ++_i) \
        __builtin_amdgcn_global_load_lds((const unsigned*)((const char*)(gbase) + (voff)[_i]), (PG8_LAS unsigned*)(lds + (bufoff) + ldsw + _i * 8192), 16, 0, 0); } while (0)
#define PG8_LDA(dst, b, h) do { _Pragma("unroll") for (int m = 0; m < 4; ++m) _Pragma("unroll") for (int k = 0; k < 2; ++k) dst[m][k] = *(const PG8_LAS bf16x8*)(lds + PG8_SA(b, h) + aoff + m * 2048 + k * 1024); } while (0)
#define PG8_LDB(dst, b, h) do { _Pragma("unroll") for (int n = 0; n < 2; ++n) _Pragma("unroll") for (int k = 0; k < 2; ++k) dst[n][k] = *(const PG8_LAS bf16x8*)(lds + PG8_SB(b, h) + boff + n * 2048 + k * 1024); } while (0)
#define PG8_MMA(ai, bj, At, Bt) do { __builtin_amdgcn_s_setprio(1); _Pragma("unroll") for (int m = 0; m < 4; ++m) _Pragma("unroll") for (int n = 0; n < 2; ++n) _Pragma("unroll") for (int k = 0; k < 2; ++k) \
        acc[ai][bj][m][n] = __builtin_amdgcn_mfma_f32_16x16x32_bf16(Bt[n][k], At[m][k], acc[ai][bj][m][n], 0, 0, 0); __builtin_amdgcn_s_setprio(0); } while (0)
#define PG8_WAIT_V(n) asm volatile("s_waitcnt vmcnt(" #n ")" ::: "memory")
#define PG8_WAIT_L(n) asm volatile("s_waitcnt lgkmcnt(" #n ")" ::: "memory")
#define PG8_BAR __builtin_amdgcn_s_barrier()
#define PG8_SCHED __builtin_amdgcn_sched_barrier(0)
    Unit cur, nxt; int ui = 0;
    if (!S.next(0, cur)) return;
    f32x4 acc[2][2][4][2];
#pragma unroll
    for (int a = 0; a < 2; ++a)
#pragma unroll
        for (int b = 0; b < 2; ++b)
#pragma unroll
            for (int m = 0; m < 4; ++m)
#pragma unroll
                for (int n = 0; n < 2; ++n) acc[a][b][m][n] = (f32x4){0.f, 0.f, 0.f, 0.f};
    bf16x8 At[4][2], B0[2][2], B1[2][2];
    const char* cA = (const char*)g.A + (size_t)cur.pm * tstep; const char* cB = (const char*)g.Bt + (size_t)cur.pn * tstep;
    S.a_ready(cur);
    PG8_STAGE(PG8_SB(0, 0), cB, voffB); PG8_STAGE(PG8_SA(0, 0), cA, voffA); PG8_STAGE(PG8_SB(0, 1), cB + hstep, voffB); PG8_STAGE(PG8_SA(0, 1), cA + hstep, voffA);
    if (wr == 1) PG8_BAR;
    PG8_WAIT_V(4); PG8_BAR;
    PG8_STAGE(PG8_SB(1, 0), cB + kstep, voffB); PG8_STAGE(PG8_SA(1, 0), cA + kstep, voffA); PG8_STAGE(PG8_SB(1, 1), cB + hstep + kstep, voffB);
    PG8_WAIT_V(6); PG8_BAR;
    PG8_STAMP();
    for (;;) {
        const bool has_next = S.next(ui + 1, nxt);
        const char* nA = has_next ? (const char*)g.A + (size_t)nxt.pm * tstep : cA; const char* nB = has_next ? (const char*)g.Bt + (size_t)nxt.pn * tstep : cB;
        for (int t = 0; t < nt; t += 2) {
            const bool last = (t == nt - 2);
            const char* a1 = cA + (size_t)(t + 1) * kstep;
            const char* a2 = last ? nA : cA + (size_t)(t + 2) * kstep; const char* b2 = last ? nB : cB + (size_t)(t + 2) * kstep;
            const char* a3 = a2 + kstep; const char* b3 = b2 + kstep;
            if (last && has_next) S.a_ready(nxt);
            PG8_LDB(B0, 0, 0); PG8_SCHED; PG8_LDA(At, 0, 0); PG8_STAGE(PG8_SA(1, 1), a1 + hstep, voffA);
            PG8_WAIT_L(8); PG8_BAR; PG8_WAIT_L(0); PG8_MMA(0, 0, At, B0); PG8_BAR; PG8_SCHED;
            PG8_LDB(B1, 0, 1); PG8_STAGE(PG8_SB(0, 0), b2, voffB);
            PG8_BAR; PG8_WAIT_L(0); PG8_MMA(0, 1, At, B1); PG8_BAR;
            PG8_LDA(At, 0, 1); PG8_STAGE(PG8_SA(0, 0), a2, voffA);
            PG8_BAR; PG8_WAIT_L(0); PG8_MMA(1, 0, At, B0); PG8_BAR; PG8_SCHED;
            PG8_STAGE(PG8_SB(0, 1), b2 + hstep, voffB);
            PG8_WAIT_V(6); PG8_BAR; PG8_MMA(1, 1, At, B1); PG8_BAR;
            PG8_LDB(B0, 1, 0); PG8_SCHED; PG8_LDA(At, 1, 0); PG8_STAGE(PG8_SA(0, 1), a2 + hstep, voffA);
            PG8_WAIT_L(8); PG8_BAR; PG8_WAIT_L(0); PG8_MMA(0, 0, At, B0); PG8_BAR; PG8_SCHED;
            PG8_LDB(B1, 1, 1); PG8_STAGE(PG8_SB(1, 0), b3, voffB);
            PG8_BAR; PG8_WAIT_L(0); PG8_MMA(0, 1, At, B1); PG8_BAR;
            PG8_LDA(At, 1, 1); PG8_STAGE(PG8_SA(1, 0), a3, voffA);
            PG8_BAR; PG8_WAIT_L(0); PG8_MMA(1, 0, At, B0); PG8_BAR; PG8_SCHED;
            PG8_STAGE(PG8_SB(1, 1), b3 + hstep, voffB);
            PG8_WAIT_V(6); PG8_BAR; PG8_MMA(1, 1, At, B1); PG8_BAR;
        }
        PG8_STAMP();
        if constexpr (!Epi::AFTER_DRAIN) { E(acc, cur, wr, wc, fr, fq); S.done(cur); }
        PG8_STAMP();
        if (!has_next) break;
#pragma unroll
        for (int a = 0; a < 2; ++a)
#pragma unroll
            for (int b = 0; b < 2; ++b)
#pragma unroll
                for (int m = 0; m < 4; ++m)
#pragma unroll
                    for (int n = 0; n < 2; ++n) acc[a][b][m][n] = (f32x4){0.f, 0.f, 0.f, 0.f};
        cur = nxt; cA = nA; cB = nB; ++ui;
    }
    PG8_WAIT_V(0);
    if (wr == 0) PG8_BAR;
    PG8_BAR;
    if constexpr (Epi::AFTER_DRAIN) { E.fused(acc, cur, wr, wc, fr, fq, lds, wid, lane); S.done(cur); }
    PG8_STAMP();
    if (STAMP && wid == 0) { stamps[lane] = lane < nts ? (((unsigned long long)(unsigned)ts_hi << 32) | (unsigned)ts_lo) : 0ull;
        if (lane == 62) stamps[62] = rt_entry; if (lane == 63) stamps[63] = (unsigned long long)wall_clock64(); }
#undef PG8_STAMP
#undef PG8_SA
#undef PG8_SB
#undef PG8_STAGE
#undef PG8_LDA
#undef PG8_LDB
#undef PG8_MMA
#undef PG8_WAIT_V
#undef PG8_WAIT_L
#undef PG8_BAR
#undef PG8_SCHED
}
}

typedef unsigned short bf16_t;
constexpr int DM = 2048, NCTX = 8192, NLAT = 4096, MTOK = 12288, DIN = 6656, LKV = 1536;
constexpr int ZQA = 0, ZKA = 1024, ZVA = 2048, ZGA = 3072, ZQB = 4096, ZKB = 5120, ZVB = 5376, ZGB = 5632;
constexpr float EPS = 1e-6f;
constexpr size_t MiB = 1048576;
constexpr size_t WS_MOD = 0, WS_CTR = 512 * 1024, WS_WOUT = 1 * MiB, WS_KA = 9 * MiB, WS_VA = 21 * MiB, WS_KB = 33 * MiB, WS_VB = 36 * MiB,
                 WS_Z = 40 * MiB, WS_O = 196 * MiB, WS_WIN = WS_O, WS_END = 244 * MiB;
constexpr size_t OUT_Y = 0, OUT_NDK = (size_t)MTOK * DM, OUT_NDV = OUT_NDK + (size_t)NCTX * 1024, OUT_NGK = OUT_NDV + (size_t)NCTX * 1024, OUT_NGV = OUT_NGK + (size_t)NCTX * 256;
constexpr int LDS_BYTES = 140 * 1024;

struct Params {
    const float *x_prompt, *x_sample, *cdk, *cdv, *cgk, *cgv, *c, *c_ctx, *w_ada, *b_ada, *g_norm, *w_in, *lq1, *lk1, *lq2, *lk2, *subln, *qng, *kng, *w_out, *g_final;
    float* out; unsigned char* ws;
};

typedef short bf16x8 __attribute__((ext_vector_type(8)));
typedef short s16x4 __attribute__((ext_vector_type(4)));
typedef float f32x4 __attribute__((ext_vector_type(4)));
typedef float f32x16 __attribute__((ext_vector_type(16)));
typedef unsigned u32x4 __attribute__((ext_vector_type(4)));
typedef unsigned u32x2 __attribute__((ext_vector_type(2)));

__device__ __forceinline__ unsigned cvtpk(float lo, float hi) { unsigned r; asm volatile("v_cvt_pk_bf16_f32 %0, %1, %2" : "=v"(r) : "v"(lo), "v"(hi)); return r; }
__device__ __forceinline__ float bf_lo(unsigned w) { return __uint_as_float(w << 16); }
__device__ __forceinline__ float bf_hi(unsigned w) { return __uint_as_float(w & 0xffff0000u); }
__device__ __forceinline__ float bf2f(bf16_t b) { return __uint_as_float(((unsigned)b) << 16); }
__device__ __forceinline__ bf16_t f2bf(float f) { unsigned u = __float_as_uint(f); u += 0x7fffu + ((u >> 16) & 1u); return (bf16_t)(u >> 16); }
__device__ __forceinline__ float wave_sum(float v) {
    v += __shfl_xor(v, 32); v += __shfl_xor(v, 16); v += __shfl_xor(v, 8); v += __shfl_xor(v, 4); v += __shfl_xor(v, 2); v += __shfl_xor(v, 1); return v;
}
__device__ __forceinline__ float silu_f(float v) { return v / (1.0f + __expf(-v)); }
__device__ __forceinline__ void sincos_rev(float a, float& s, float& c) { float r = a * 0.15915494309189535f; r = r - floorf(r); s = __builtin_amdgcn_sinf(r); c = __builtin_amdgcn_cosf(r); }

struct EpiZ {
    static constexpr bool PERM = true, AFTER_DRAIN = false;
    bf16_t* O; int ld;
    __device__ __forceinline__ void operator()(const pg8::f32x4 (&acc)[2][2][4][2], const pg8::Unit& u, int wr, int wc, int fr, int fq) const {
        const int row0 = u.pm * 256 + wr * 64 + fr; const int col0 = u.pn * 256 + wc * 32 + 8 * fq;
#pragma unroll
        for (int ai = 0; ai < 2; ++ai)
#pragma unroll
            for (int m = 0; m < 4; ++m) { bf16_t* rowp = O + (size_t)(row0 + ai * 128 + m * 16) * ld + col0;
#pragma unroll
                for (int bj = 0; bj < 2; ++bj) { const pg8::f32x4 v0 = acc[ai][bj][m][0], v1 = acc[ai][bj][m][1];
                    u32x4 w; w.x = cvtpk(v0[0], v0[1]); w.y = cvtpk(v0[2], v0[3]); w.z = cvtpk(v1[0], v1[1]); w.w = cvtpk(v1[2], v1[3]);
                    *(u32x4*)(rowp + bj * 128) = w; } }
    }
};
__host__ __device__ __forceinline__ int phys_col(int n) {
    const int tile = n >> 8, x = n & 255, bj = x >> 7, y = x & 127;
    if (tile < 8) { const int c = y >> 6, nn = (y >> 5) & 1, s = (y >> 4) & 1, fq = (y >> 2) & 3, j = y & 3; return tile * 256 + 128 * bj + 32 * (2 * c + s) + 8 * fq + 4 * nn + j; }
    if (tile >= 16 && tile <= 20) { const int nn = y >> 6, wc = (y >> 4) & 3, fq = (y >> 2) & 3, j = y & 3; return tile * 256 + 128 * bj + 32 * wc + 8 * fq + 4 * nn + j; }
    return n;
}
struct EpiFused {
    static constexpr bool PERM = true, AFTER_DRAIN = false;
    bf16_t* z; bf16_t* KA; bf16_t* VA; bf16_t* KB; bf16_t* VB; float* out; const float* qng; const float* kng; PG8_LAS float* P;
    __device__ __forceinline__ void operator()(const pg8::f32x4 (&acc)[2][2][4][2], const pg8::Unit& u, int wr, int wc, int fr, int fq) const {
        const int pn = u.pn, pm = u.pm; const bool lat = pm >= 32;
        const int rl0 = wr * 64 + fr, grow0 = pm * 256 + rl0;
        const int b = lat ? (pm - 32) >> 2 : 0, pos0 = lat ? ((pm - 32) & 3) * 256 + rl0 : 0;
        const float L2T = 13.287712379549449f;
        if (pn < 8) {
            const int cl = 64 * (wc >> 1) + 16 * (wc & 1) + 4 * fq; const bool rowfreq = (wc & 1) == 0;
            float inv[4];
#pragma unroll
            for (int j = 0; j < 4; ++j) inv[j] = __builtin_amdgcn_exp2f(-(float)(4 * fq + j) * (L2T / 16.0f));
#pragma unroll
            for (int ai = 0; ai < 2; ++ai)
#pragma unroll
                for (int m = 0; m < 4; ++m) { const int row = grow0 + 128 * ai + 16 * m, pos = pos0 + 128 * ai + 16 * m;
                    float cs[4], sn[4];
                    if (lat) { const float pv = (float)(rowfreq ? (pos >> 6) : (pos & 63));
#pragma unroll
                        for (int j = 0; j < 4; ++j) sincos_rev(pv * inv[j], sn[j], cs[j]); }
#pragma unroll
                    for (int bj = 0; bj < 2; ++bj) { const pg8::f32x4 x1 = acc[ai][bj][m][0], x2 = acc[ai][bj][m][1]; pg8::f32x4 o1 = x1, o2 = x2;
                        if (lat) {
#pragma unroll
                            for (int j = 0; j < 4; ++j) { o1[j] = x1[j] * cs[j] - x2[j] * sn[j]; o2[j] = x1[j] * sn[j] + x2[j] * cs[j]; } }
                        const int col = (pn & 3) * 256 + 128 * bj + cl;
                        u32x2 w1, w2; w1.x = cvtpk(o1[0], o1[1]); w1.y = cvtpk(o1[2], o1[3]); w2.x = cvtpk(o2[0], o2[1]); w2.y = cvtpk(o2[2], o2[3]);
                        if (pn < 4) { bf16_t* d = z + (size_t)row * DIN + ZQA + col; *(u32x2*)d = w1; *(u32x2*)(d + 32) = w2; }
                        else if (!lat) { bf16_t* d = z + (size_t)row * DIN + ZKA + col; *(u32x2*)d = w1; *(u32x2*)(d + 32) = w2;
                            float* o = out + OUT_NDK + (size_t)row * 1024 + col; *(pg8::f32x4*)o = o1; *(pg8::f32x4*)(o + 32) = o2; }
                        else { bf16_t* d = KA + ((size_t)(b * LKV + pos)) * 1024 + col; *(u32x2*)d = w1; *(u32x2*)(d + 32) = w2; } } }
        } else if (pn >= 16 && pn <= 20) {
            const bool isq = pn < 20; const float* gsrc = isq ? qng : kng;
            const int cl = 16 * wc + 4 * fq;
            const pg8::f32x4 g1 = *(const pg8::f32x4*)(gsrc + cl), g2 = *(const pg8::f32x4*)(gsrc + cl + 64);
#pragma unroll
            for (int ai = 0; ai < 2; ++ai)
#pragma unroll
                for (int m = 0; m < 4; ++m)
#pragma unroll
                    for (int bj = 0; bj < 2; ++bj) { const pg8::f32x4 x1 = acc[ai][bj][m][0], x2 = acc[ai][bj][m][1];
                        float s = (x1[0] * x1[0] + x1[1] * x1[1]) + (x1[2] * x1[2] + x1[3] * x1[3]) + (x2[0] * x2[0] + x2[1] * x2[1]) + (x2[2] * x2[2] + x2[3] * x2[3]);
                        s += __shfl_xor(s, 16); s += __shfl_xor(s, 32);
                        if (fq == 0) P[((128 * ai + rl0 + 16 * m) * 2 + bj) * 4 + wc] = s; }
            asm volatile("s_waitcnt lgkmcnt(0)" ::: "memory"); __builtin_amdgcn_s_barrier(); asm volatile("" ::: "memory");
            const bool rowfreq = wc < 2;
            float inv[4];
#pragma unroll
            for (int j = 0; j < 4; ++j) inv[j] = __builtin_amdgcn_exp2f(-(float)((16 * wc + 4 * fq + j) & 31) * (L2T / 32.0f));
#pragma unroll
            for (int ai = 0; ai < 2; ++ai)
#pragma unroll
                for (int m = 0; m < 4; ++m) { const int row = grow0 + 128 * ai + 16 * m, pos = pos0 + 128 * ai + 16 * m;
                    float cs[4], sn[4];
                    if (lat) { const float pv = (float)(rowfreq ? (pos >> 6) : (pos & 63));
#pragma unroll
                        for (int j = 0; j < 4; ++j) sincos_rev(pv * inv[j], sn[j], cs[j]); }
#pragma unroll
                    for (int bj = 0; bj < 2; ++bj) { const pg8::f32x4 x1 = acc[ai][bj][m][0], x2 = acc[ai][bj][m][1];
                        const pg8::f32x4 pp = *(const PG8_LAS pg8::f32x4*)(P + ((128 * ai + rl0 + 16 * m) * 2 + bj) * 4);
                        const float rstd = rsqrtf(((pp[0] + pp[1]) + (pp[2] + pp[3])) * (1.0f / 128.0f) + EPS);
                        const pg8::f32x4 y1 = x1 * rstd * g1, y2 = x2 * rstd * g2; pg8::f32x4 o1 = y1, o2 = y2;
                        if (lat) {
#pragma unroll
                            for (int j = 0; j < 4; ++j) { o1[j] = y1[j] * cs[j] - y2[j] * sn[j]; o2[j] = y1[j] * sn[j] + y2[j] * cs[j]; } }
                        u32x2 w1, w2; w1.x = cvtpk(o1[0], o1[1]); w1.y = cvtpk(o1[2], o1[3]); w2.x = cvtpk(o2[0], o2[1]); w2.y = cvtpk(o2[2], o2[3]);
                        if (isq) { bf16_t* d = z + (size_t)row * DIN + ZQB + (pn - 16) * 256 + 128 * bj + cl; *(u32x2*)d = w1; *(u32x2*)(d + 64) = w2; }
                        else if (!lat) { bf16_t* d = z + (size_t)row * DIN + ZKB + 128 * bj + cl; *(u32x2*)d = w1; *(u32x2*)(d + 64) = w2;
                            float* o = out + OUT_NGK + (size_t)row * 256 + 128 * bj + cl; *(pg8::f32x4*)o = o1; *(pg8::f32x4*)(o + 64) = o2; }
                        else { bf16_t* d = KB + ((size_t)(b * LKV + pos)) * 256 + 128 * bj + cl; *(u32x2*)d = w1; *(u32x2*)(d + 64) = w2; } } }
        } else {
            const int c8 = 32 * wc + 8 * fq;
            const bool gate = (pn >= 12 && pn < 16) || pn >= 22;
#pragma unroll
            for (int ai = 0; ai < 2; ++ai)
#pragma unroll
                for (int m = 0; m < 4; ++m) { const int row = grow0 + 128 * ai + 16 * m, pos = pos0 + 128 * ai + 16 * m;
#pragma unroll
                    for (int bj = 0; bj < 2; ++bj) { pg8::f32x4 v0 = acc[ai][bj][m][0], v1 = acc[ai][bj][m][1];
                        if (gate) {
#pragma unroll
                            for (int j = 0; j < 4; ++j) { v0[j] = silu_f(v0[j]); v1[j] = silu_f(v1[j]); } }
                        u32x4 w; w.x = cvtpk(v0[0], v0[1]); w.y = cvtpk(v0[2], v0[3]); w.z = cvtpk(v1[0], v1[1]); w.w = cvtpk(v1[2], v1[3]);
                        const int col = 128 * bj + c8;
                        if (gate) { *(u32x4*)(z + (size_t)row * DIN + (size_t)pn * 256 + col) = w; }
                        else if (pn < 12) {
                            const int vc = (pn - 8) * 256 + col;
                            if (!lat) { *(u32x4*)(z + (size_t)row * DIN + ZVA + vc) = w; float* o = out + OUT_NDV + (size_t)row * 1024 + vc; *(pg8::f32x4*)o = v0; *(pg8::f32x4*)(o + 4) = v1; }
                            else *(u32x4*)(VA + ((size_t)(b * LKV + pos)) * 1024 + vc) = w; }
                        else {
                            if (!lat) { *(u32x4*)(z + (size_t)row * DIN + ZVB + col) = w; float* o = out + OUT_NGV + (size_t)row * 256 + col; *(pg8::f32x4*)o = v0; *(pg8::f32x4*)(o + 4) = v1; }
                            else *(u32x4*)(VB + ((size_t)(b * LKV + pos)) * 256 + col) = w; } } }
        }
    }
};
struct EpiRes {
    static constexpr bool PERM = false, AFTER_DRAIN = false;
    const float* xp; const float* xs; const float* mod; float* out;
    __device__ __forceinline__ void operator()(const pg8::f32x4 (&acc)[2][2][4][2], const pg8::Unit& u, int wr, int wc, int fr, int fq) const {
        const int row0 = u.pm * 256 + wr * 64 + fr; const int col0 = u.pn * 256 + wc * 32 + 4 * fq;
        const int cnd = u.pm < 32 ? 0 : 1 + ((u.pm - 32) >> 2);
        const float* gate = mod + cnd * 6144 + 4096 + col0;
        pg8::f32x4 gv[2][2];
#pragma unroll
        for (int bj = 0; bj < 2; ++bj)
#pragma unroll
            for (int n = 0; n < 2; ++n) gv[bj][n] = *(const pg8::f32x4*)(gate + bj * 128 + n * 16);
#pragma unroll
        for (int ai = 0; ai < 2; ++ai)
#pragma unroll
            for (int m = 0; m < 4; ++m) { const int row = row0 + ai * 128 + m * 16;
                const float* xr = (row < NCTX ? xp + (size_t)row * DM : xs + (size_t)(row - NCTX) * DM) + col0;
                float* orow = out + (size_t)row * DM + col0;
#pragma unroll
                for (int bj = 0; bj < 2; ++bj)
#pragma unroll
                    for (int n = 0; n < 2; ++n) { const pg8::f32x4 xv = *(const pg8::f32x4*)(xr + bj * 128 + n * 16);
                        *(pg8::f32x4*)(orow + bj * 128 + n * 16) = xv + gv[bj][n] * acc[ai][bj][m][n]; } }
    }
};

__device__ __forceinline__ void phase0(const Params& p, unsigned char* lds) {
    int tid_o = threadIdx.x; asm volatile("" : "+v"(tid_o)); const int tid = tid_o, wid = tid >> 6, lane = tid & 63, G = gridDim.x, bid = blockIdx.x;
    if (bid == 0 && tid < 8) ((unsigned*)(p.ws + WS_CTR))[tid] = 0u;
    float* mod = (float*)(p.ws + WS_MOD);
    for (int item = bid; item < 192; item += G) {
        float* sil = (float*)lds;
        float* red = (float*)(lds + 40960);
        for (int i = tid; i < 5 * 2048; i += 512) { const int cn = i >> 11, k = i & 2047; const float v = cn == 0 ? p.c_ctx[k] : p.c[(cn - 1) * 2048 + k]; sil[i] = silu_f(v); }
        __syncthreads();
        const int col0 = item * 32 + (lane & 7) * 4, rsub = lane >> 3;
        float a0[4] = {0.f, 0.f, 0.f, 0.f}, a1[4] = {0.f, 0.f, 0.f, 0.f}, a2[4] = {0.f, 0.f, 0.f, 0.f}, a3[4] = {0.f, 0.f, 0.f, 0.f}, a4[4] = {0.f, 0.f, 0.f, 0.f};
        const float* wp = p.w_ada + (size_t)(wid * 256 + rsub) * 6144 + col0;
#pragma unroll 8
        for (int it = 0; it < 32; ++it) {
            const f32x4 w = __builtin_nontemporal_load((const f32x4*)(wp + (size_t)it * 8 * 6144));
            const int k = wid * 256 + it * 8 + rsub;
            const float s0 = sil[k], s1 = sil[2048 + k], s2 = sil[4096 + k], s3 = sil[6144 + k], s4 = sil[8192 + k];
#pragma unroll
            for (int j = 0; j < 4; ++j) { a0[j] += s0 * w[j]; a1[j] += s1 * w[j]; a2[j] += s2 * w[j]; a3[j] += s3 * w[j]; a4[j] += s4 * w[j]; }
        }
#pragma unroll
        for (int j = 0; j < 4; ++j) {
            a0[j] += __shfl_xor(a0[j], 8); a0[j] += __shfl_xor(a0[j], 16); a0[j] += __shfl_xor(a0[j], 32);
            a1[j] += __shfl_xor(a1[j], 8); a1[j] += __shfl_xor(a1[j], 16); a1[j] += __shfl_xor(a1[j], 32);
            a2[j] += __shfl_xor(a2[j], 8); a2[j] += __shfl_xor(a2[j], 16); a2[j] += __shfl_xor(a2[j], 32);
            a3[j] += __shfl_xor(a3[j], 8); a3[j] += __shfl_xor(a3[j], 16); a3[j] += __shfl_xor(a3[j], 32);
            a4[j] += __shfl_xor(a4[j], 8); a4[j] += __shfl_xor(a4[j], 16); a4[j] += __shfl_xor(a4[j], 32);
        }
        if (lane < 8) {
#pragma unroll
            for (int j = 0; j < 4; ++j) { red[(wid * 5 + 0) * 32 + lane * 4 + j] = a0[j]; red[(wid * 5 + 1) * 32 + lane * 4 + j] = a1[j]; red[(wid * 5 + 2) * 32 + lane * 4 + j] = a2[j];
                red[(wid * 5 + 3) * 32 + lane * 4 + j] = a3[j]; red[(wid * 5 + 4) * 32 + lane * 4 + j] = a4[j]; }
        }
        __syncthreads();
        if (tid < 160) { const int cn = tid >> 5, col = tid & 31; float s = 0.f;
#pragma unroll
            for (int w = 0; w < 8; ++w) s += red[(w * 5 + cn) * 32 + col];
            const int gc = item * 32 + col; mod[cn * 6144 + gc] = s + p.b_ada[gc]; }
        __syncthreads();
    }
    {
        float* tl = (float*)lds;
        constexpr int N_STRIP_IN = 832, N_STRIP = 1088, N_ITEMS = 1408;
        int it, step, limit;
        if (G == 256) { if (bid < 192) { it = bid; step = 192; limit = 864; } else { it = 864 + (bid - 192); step = 64; limit = N_ITEMS; } }
        else { it = bid; step = G; limit = N_ITEMS; }
        f32x4 cur[8], nxt[8];
#define P0_LOAD(ITEM, V) do { const int it_ = (ITEM); \
            if (it_ < N_STRIP) { const float* src_; int N_, kt_, nt_; \
                if (it_ < N_STRIP_IN) { src_ = p.w_in; N_ = DIN; kt_ = it_ / 26; nt_ = it_ - kt_ * 26; } else { const int s2_ = it_ - N_STRIP_IN; src_ = p.w_out; N_ = DM; kt_ = s2_ >> 3; nt_ = s2_ & 7; } \
                const float* b_ = src_ + (size_t)(kt_ * 64 + (tid >> 6)) * N_ + nt_ * 256 + (tid & 63) * 4; \
                _Pragma("unroll") for (int i_ = 0; i_ < 8; ++i_) V[i_] = __builtin_nontemporal_load((const f32x4*)(b_ + (size_t)i_ * 8 * N_)); } \
            else { const int e0_ = (it_ - N_STRIP) * 16384; const float* src_; int off_; \
                if (e0_ < 2097152) { src_ = p.cdk; off_ = e0_; } else if (e0_ < 4194304) { src_ = p.cdv; off_ = e0_ - 2097152; } \
                else if (e0_ < 4718592) { src_ = p.cgk; off_ = e0_ - 4194304; } else { src_ = p.cgv; off_ = e0_ - 4718592; } \
                _Pragma("unroll") for (int i_ = 0; i_ < 4; ++i_) { V[2 * i_] = __builtin_nontemporal_load((const f32x4*)(src_ + off_ + (tid + 512 * i_) * 8)); V[2 * i_ + 1] = __builtin_nontemporal_load((const f32x4*)(src_ + off_ + (tid + 512 * i_) * 8 + 4)); } } } while (0)
        if (it < limit) P0_LOAD(it, cur);
        while (it < limit) {
            const int itn = it + step;
            if (it < N_STRIP) {
                const int k0 = tid >> 6, c4 = (tid & 63) * 4;
#pragma unroll
                for (int i = 0; i < 8; ++i) { const int k = i * 8 + k0; *(f32x4*)(tl + k * 256 + (c4 ^ (((k >> 3) & 3) << 3))) = cur[i]; }
                __syncthreads();
                if (itn < limit) P0_LOAD(itn, nxt);
                bf16_t* dst; int kt, nt; bool perm;
                if (it < N_STRIP_IN) { dst = (bf16_t*)(p.ws + WS_WIN); kt = it / 26; nt = it - kt * 26; perm = true; } else { const int s2 = it - N_STRIP_IN; dst = (bf16_t*)(p.ws + WS_WOUT); kt = s2 >> 3; nt = s2 & 7; perm = false; }
                const int k8 = (tid & 7) * 8, sw = ((k8 >> 3) & 3) << 3;
#pragma unroll
                for (int ps = 0; ps < 4; ++ps) { const int n = ps * 64 + (tid >> 3); const float* col = tl + k8 * 256 + (n ^ sw);
                    u32x4 w; w.x = cvtpk(col[0], col[256]); w.y = cvtpk(col[512], col[768]); w.z = cvtpk(col[1024], col[1280]); w.w = cvtpk(col[1536], col[1792]);
                    const int nl = nt * 256 + n; const int nrow = perm ? phys_col(nl) : nl;
                    *(u32x4*)(dst + (size_t)nrow * 2048 + kt * 64 + k8) = w; }
                __syncthreads();
            } else {
                if (itn < limit) P0_LOAD(itn, nxt);
                const int e0 = (it - N_STRIP) * 16384; bf16_t* dst; int off, Wd;
                if (e0 < 2097152) { dst = (bf16_t*)(p.ws + WS_KA); off = e0; Wd = 1024; } else if (e0 < 4194304) { dst = (bf16_t*)(p.ws + WS_VA); off = e0 - 2097152; Wd = 1024; }
                else if (e0 < 4718592) { dst = (bf16_t*)(p.ws + WS_KB); off = e0 - 4194304; Wd = 256; } else { dst = (bf16_t*)(p.ws + WS_VB); off = e0 - 4718592; Wd = 256; }
#pragma unroll
                for (int i = 0; i < 4; ++i) { const int e = off + (tid + 512 * i) * 8; const int per_b = 512 * Wd; const int b = e / per_b, rem = e - b * per_b, s = rem / Wd, col = rem - s * Wd;
                    const f32x4 v0 = cur[2 * i], v1 = cur[2 * i + 1];
                    u32x4 w; w.x = cvtpk(v0[0], v0[1]); w.y = cvtpk(v0[2], v0[3]); w.z = cvtpk(v1[0], v1[1]); w.w = cvtpk(v1[2], v1[3]);
                    *(u32x4*)(dst + ((size_t)(b * LKV + 1024 + s)) * Wd + col) = w; }
            }
#pragma unroll
            for (int i = 0; i < 8; ++i) cur[i] = nxt[i];
            it = itn;
        }
#undef P0_LOAD
    }
}

__device__ __forceinline__ void phase1(const Params& p) {
    int tid_o = threadIdx.x; asm volatile("" : "+v"(tid_o)); const int tid = tid_o, wid = tid >> 6, lane = tid & 63, G = gridDim.x, bid = blockIdx.x;
    const float* mod = (const float*)(p.ws + WS_MOD);
    bf16_t* h = (bf16_t*)p.out;
    const int rstep = G * 8;
    int row = bid * 8 + wid;
    f32x4 xa[8], xb[8], na[8], nb[8];
#define P1_LOAD(R, V) do { const int r_ = (R); if (r_ < MTOK) { const float* xr_ = r_ < NCTX ? p.x_prompt + (size_t)r_ * DM : p.x_sample + (size_t)(r_ - NCTX) * DM; \
        _Pragma("unroll") for (int i_ = 0; i_ < 8; ++i_) V[i_] = __builtin_nontemporal_load((const f32x4*)(xr_ + i_ * 256 + lane * 4)); } } while (0)
#define P1_DO(R, V) do { const int r_ = (R); if (r_ < MTOK) { float ss_ = 0.f; \
        _Pragma("unroll") for (int i_ = 0; i_ < 8; ++i_) ss_ += V[i_][0] * V[i_][0] + V[i_][1] * V[i_][1] + V[i_][2] * V[i_][2] + V[i_][3] * V[i_][3]; \
        ss_ = wave_sum(ss_); const float rstd_ = rsqrtf(ss_ * (1.0f / DM) + EPS); \
        const int cn_ = r_ < NCTX ? 0 : 1 + ((r_ - NCTX) >> 10); const float* sh_ = mod + cn_ * 6144; const float* sc_ = sh_ + 2048; \
        _Pragma("unroll") for (int i_ = 0; i_ < 8; ++i_) { const int col_ = i_ * 256 + lane * 4; \
            const f32x4 g_ = *(const f32x4*)(p.g_norm + col_), s1_ = *(const f32x4*)(sc_ + col_), s0_ = *(const f32x4*)(sh_ + col_); \
            const f32x4 y_ = (V[i_] * rstd_) * g_ * (s1_ + 1.0f) + s0_; u32x2 w_; w_.x = cvtpk(y_[0], y_[1]); w_.y = cvtpk(y_[2], y_[3]); \
            *(u32x2*)(h + (size_t)r_ * DM + col_) = w_; } } } while (0)
    P1_LOAD(row, xa); P1_LOAD(row + rstep, xb);
    for (; row < MTOK; row += 2 * rstep) {
        P1_LOAD(row + 2 * rstep, na); P1_LOAD(row + 3 * rstep, nb);
        P1_DO(row, xa); P1_DO(row + rstep, xb);
#pragma unroll
        for (int i = 0; i < 8; ++i) { xa[i] = na[i]; xb[i] = nb[i]; }
    }
#undef P1_LOAD
#undef P1_DO
}

__device__ __forceinline__ void phase2b(const Params& p) {
    int tid_o = threadIdx.x; asm volatile("" : "+v"(tid_o)); const int tid = tid_o, wid = tid >> 6, lane = tid & 63, G = gridDim.x, bid = blockIdx.x;
    bf16_t* z = (bf16_t*)(p.ws + WS_Z);
    const float qg0 = p.qng[lane * 2], qg1 = p.qng[lane * 2 + 1], kg0 = p.kng[lane * 2], kg1 = p.kng[lane * 2 + 1];
    const float L2T = 13.287712379549449f;
    for (int row = bid * 8 + wid; row < MTOK; row += G * 8) {
        bf16_t* zr = z + (size_t)row * DIN;
        if (row < NCTX) {
#pragma unroll
            for (int i = 0; i < 2; ++i) { const int col = i * 512 + lane * 8;
                const u32x4 a = *(const u32x4*)(zr + ZKA + col); float* o = p.out + OUT_NDK + (size_t)row * 1024 + col;
                *(f32x4*)o = (f32x4){bf_lo(a.x), bf_hi(a.x), bf_lo(a.y), bf_hi(a.y)}; *(f32x4*)(o + 4) = (f32x4){bf_lo(a.z), bf_hi(a.z), bf_lo(a.w), bf_hi(a.w)};
                const u32x4 b = *(const u32x4*)(zr + ZVA + col); float* o2 = p.out + OUT_NDV + (size_t)row * 1024 + col;
                *(f32x4*)o2 = (f32x4){bf_lo(b.x), bf_hi(b.x), bf_lo(b.y), bf_hi(b.y)}; *(f32x4*)(o2 + 4) = (f32x4){bf_lo(b.z), bf_hi(b.z), bf_lo(b.w), bf_hi(b.w)}; }
            { const u32x2 a = *(const u32x2*)(zr + ZVB + lane * 4);
              *(f32x4*)(p.out + OUT_NGV + (size_t)row * 256 + lane * 4) = (f32x4){bf_lo(a.x), bf_hi(a.x), bf_lo(a.y), bf_hi(a.y)}; }
#pragma unroll
            for (int hd = 0; hd < 10; ++hd) { const int base = hd < 8 ? ZQB + hd * 128 : ZKB + (hd - 8) * 128;
                const unsigned w = *(const unsigned*)(zr + base + lane * 2); float a = bf_lo(w), b = bf_hi(w);
                const float ss = wave_sum(a * a + b * b); const float r = rsqrtf(ss * (1.0f / 128.0f) + EPS);
                a = a * r * (hd < 8 ? qg0 : kg0); b = b * r * (hd < 8 ? qg1 : kg1);
                *(unsigned*)(zr + base + lane * 2) = cvtpk(a, b);
                if (hd >= 8) { float* o = p.out + OUT_NGK + (size_t)row * 256 + (hd - 8) * 128 + lane * 2; o[0] = a; o[1] = b; } }
        } else {
            const int lr = row - NCTX, b = lr >> 10, pos = lr & 1023; const float prow = (float)(pos >> 6), pcol = (float)(pos & 63);
            const size_t krow = (size_t)(b * LKV + pos);
            float cA0, sA0, cA1, sA1; const bool firstA = (lane & 16) == 0;
            { const int f = (lane * 2) & 31;
              const float a0 = (f < 16 ? prow : pcol) * exp2f(-(float)(f & 15) * (L2T / 16.0f)), a1 = ((f + 1) < 16 ? prow : pcol) * exp2f(-(float)((f + 1) & 15) * (L2T / 16.0f));
              sincos_rev(a0, sA0, cA0); sincos_rev(a1, sA1, cA1); }
#pragma unroll 4
            for (int ch = 0; ch < 16; ++ch) { const int base = (ch < 8 ? ZQA : ZKA) + (ch & 7) * 128;
                const unsigned w = *(const unsigned*)(zr + base + lane * 2); const float a = bf_lo(w), bb = bf_hi(w);
                const float pa = __shfl_xor(a, 16), pb = __shfl_xor(bb, 16);
                const float o0 = firstA ? a * cA0 - pa * sA0 : pa * sA0 + a * cA0, o1 = firstA ? bb * cA1 - pb * sA1 : pb * sA1 + bb * cA1;
                if (ch < 8) *(unsigned*)(zr + base + lane * 2) = cvtpk(o0, o1);
                else *(unsigned*)((bf16_t*)(p.ws + WS_KA) + krow * 1024 + (ch & 7) * 128 + lane * 2) = cvtpk(o0, o1); }
#pragma unroll
            for (int i = 0; i < 2; ++i) { const int col = i * 512 + lane * 8; *(u32x4*)((bf16_t*)(p.ws + WS_VA) + krow * 1024 + col) = *(const u32x4*)(zr + ZVA + col); }
            *(u32x2*)((bf16_t*)(p.ws + WS_VB) + krow * 256 + lane * 4) = *(const u32x2*)(zr + ZVB + lane * 4);
            float cB0, sB0, cB1, sB1; const bool firstB = lane < 32;
            { const int f = (lane * 2) & 63;
              const float a0 = (f < 32 ? prow : pcol) * exp2f(-(float)(f & 31) * (L2T / 32.0f)), a1 = ((f + 1) < 32 ? prow : pcol) * exp2f(-(float)((f + 1) & 31) * (L2T / 32.0f));
              sincos_rev(a0, sB0, cB0); sincos_rev(a1, sB1, cB1); }
#pragma unroll 2
            for (int hd = 0; hd < 10; ++hd) { const int base = hd < 8 ? ZQB + hd * 128 : ZKB + (hd - 8) * 128;
                const unsigned w = *(const unsigned*)(zr + base + lane * 2); float a = bf_lo(w), bb = bf_hi(w);
                const float ss = wave_sum(a * a + bb * bb); const float r = rsqrtf(ss * (1.0f / 128.0f) + EPS);
                a = a * r * (hd < 8 ? qg0 : kg0); bb = bb * r * (hd < 8 ? qg1 : kg1);
                const float pa = __shfl_xor(a, 32), pb = __shfl_xor(bb, 32);
                const float o0 = firstB ? a * cB0 - pa * sB0 : pa * sB0 + a * cB0, o1 = firstB ? bb * cB1 - pb * sB1 : pb * sB1 + bb * cB1;
                if (hd < 8) *(unsigned*)(zr + base + lane * 2) = cvtpk(o0, o1);
                else *(unsigned*)((bf16_t*)(p.ws + WS_KB) + krow * 256 + (hd - 8) * 128 + lane * 2) = cvtpk(o0, o1); }
        }
    }
}

namespace at {
constexpr int NW = 8, QBLK = 32, KVBLK = 64;
constexpr float THR = 8.f;
constexpr int SHM_V = 16384, SHM_K = 16384;
#define AT_SBAR() __builtin_amdgcn_sched_barrier(0)
template <int DK> __device__ __forceinline__ int kswz(int row, int colB) { return DK == 128 ? row * 256 + (colB ^ ((row & 7) << 4)) : row * 128 + (colB ^ (((row >> 1) & 7) << 4)); }
__device__ __forceinline__ int crow(int r, int hi) { return (r & 3) + 8 * (r >> 2) + 4 * hi; }

template <int DK> __device__ __forceinline__ void partialSM(f32x16& p0, f32x16& p1, float& m_reg, float& mn, float& alpha) {
    constexpr float SCALE = DK == 128 ? 0.088388347648318440f : 0.125f;
    constexpr float C = SCALE * 1.4426950408889634f;
    float pmax = p0[0];
#pragma unroll
    for (int r = 1; r < 16; ++r) pmax = fmaxf(pmax, p0[r]);
#pragma unroll
    for (int r = 0; r < 16; ++r) pmax = fmaxf(pmax, p1[r]);
    { auto rr = __builtin_amdgcn_permlane32_swap(__float_as_uint(pmax), __float_as_uint(pmax), false, false);
      pmax = fmaxf(__uint_as_float(rr[0]), __uint_as_float(rr[1])); }
    if (__builtin_expect(__all(pmax - m_reg <= THR / SCALE), 1)) { mn = m_reg; alpha = 1.f; }
    else { mn = fmaxf(m_reg, pmax); alpha = __builtin_amdgcn_exp2f((m_reg - mn) * C); m_reg = mn; }
    const float mnC = -mn * C;
#pragma unroll
    for (int r = 0; r < 16; ++r) p0[r] = fmaf(p0[r], C, mnC);
#pragma unroll
    for (int r = 0; r < 16; ++r) p1[r] = fmaf(p1[r], C, mnC);
#pragma unroll
    for (int r = 0; r < 16; ++r) p0[r] = __builtin_amdgcn_exp2f(p0[r]);
}
__device__ __forceinline__ void finishSM(f32x16& p0, f32x16& p1, float alpha, float& l_reg, bf16x8& pa0, bf16x8& pa1, bf16x8& pa2, bf16x8& pa3) {
#pragma unroll
    for (int r = 0; r < 16; ++r) p1[r] = __builtin_amdgcn_exp2f(p1[r]);
    float ps = 0;
#pragma unroll
    for (int r = 0; r < 16; ++r) ps += p0[r];
#pragma unroll
    for (int r = 0; r < 16; ++r) ps += p1[r];
    { auto rr = __builtin_amdgcn_permlane32_swap(__float_as_uint(ps), __float_as_uint(ps), false, false);
      ps = __uint_as_float(rr[0]) + __uint_as_float(rr[1]); }
    l_reg = l_reg * alpha + ps;
#define AT_PK4(P, BASE, OUT) do { unsigned a0 = cvtpk(P[BASE + 0], P[BASE + 1]), a1 = cvtpk(P[BASE + 2], P[BASE + 3]);   \
    unsigned b0 = cvtpk(P[BASE + 4], P[BASE + 5]), b1 = cvtpk(P[BASE + 6], P[BASE + 7]);                              \
    auto r0 = __builtin_amdgcn_permlane32_swap(a0, b0, false, false); auto r1 = __builtin_amdgcn_permlane32_swap(a1, b1, false, false); \
    u32x4 w = {r0[0], r1[0], r0[1], r1[1]}; OUT = *reinterpret_cast<bf16x8*>(&w); } while (0)
    AT_PK4(p0, 0, pa0); AT_PK4(p0, 8, pa1); AT_PK4(p1, 0, pa2); AT_PK4(p1, 8, pa3);
#undef AT_PK4
}
template <int DK> __device__ __forceinline__ void qkt(f32x16& p0, f32x16& p1, const char* Ks, const bf16x8* qr, int r32, int hi) {
    p0 = f32x16{}; p1 = f32x16{};
#pragma unroll
    for (int d0 = 0; d0 < DK / 16; ++d0) { const int cb = (d0 * 16 + hi * 8) * 2;
        const bf16x8 b0 = *reinterpret_cast<const bf16x8*>(Ks + kswz<DK>(r32, cb));
        const bf16x8 b1 = *reinterpret_cast<const bf16x8*>(Ks + kswz<DK>(32 + r32, cb));
        p0 = __builtin_amdgcn_mfma_f32_32x32x16_bf16(b0, qr[d0], p0, 0, 0, 0);
        p1 = __builtin_amdgcn_mfma_f32_32x32x16_bf16(b1, qr[d0], p1, 0, 0, 0); }
}
__device__ __forceinline__ int v_st(int k, int c) { const int kk = (k & ~0xC) | ((k & 4) << 1) | ((k & 8) >> 1); return ((kk >> 3) * 4 + (c >> 5)) * 512 + ((kk & 7) * 32 + (c & 31)) * 2; }
__device__ __forceinline__ int v_rd_base(int lane) { return ((lane & 3) << 3) | (((lane >> 2) & 3) << 6) | (((lane >> 4) & 1) << 5) | (((lane >> 5) & 1) << 8); }
constexpr int v_rd_off(int d0, int ks, int half) { return d0 * 512 + ks * 4096 + half * 2048; }
template <int OFF> __device__ __forceinline__ s16x4 tr_read(int vb) {
    s16x4 r; asm volatile("ds_read_b64_tr_b16 %0, %1 offset:%2" : "=&v"(r) : "v"(vb), "i"(OFF) : "memory"); return r;
}
template <int D0> __device__ __forceinline__ void pv_one(f32x16& od, int vb, bf16x8 pa0, bf16x8 pa1, bf16x8 pa2, bf16x8 pa3) {
    const s16x4 l0 = tr_read<v_rd_off(D0, 0, 0)>(vb), h0 = tr_read<v_rd_off(D0, 0, 1)>(vb), l1 = tr_read<v_rd_off(D0, 1, 0)>(vb), h1 = tr_read<v_rd_off(D0, 1, 1)>(vb);
    const s16x4 l2 = tr_read<v_rd_off(D0, 2, 0)>(vb), h2 = tr_read<v_rd_off(D0, 2, 1)>(vb), l3 = tr_read<v_rd_off(D0, 3, 0)>(vb), h3 = tr_read<v_rd_off(D0, 3, 1)>(vb);
    asm volatile("s_waitcnt lgkmcnt(0)" ::: "memory"); AT_SBAR();
#define AT_PK(L, H) (bf16x8){L[0], L[1], L[2], L[3], H[0], H[1], H[2], H[3]}
    od = __builtin_amdgcn_mfma_f32_32x32x16_bf16(pa0, AT_PK(l0, h0), od, 0, 0, 0);
    od = __builtin_amdgcn_mfma_f32_32x32x16_bf16(pa1, AT_PK(l1, h1), od, 0, 0, 0);
    od = __builtin_amdgcn_mfma_f32_32x32x16_bf16(pa2, AT_PK(l2, h2), od, 0, 0, 0);
    od = __builtin_amdgcn_mfma_f32_32x32x16_bf16(pa3, AT_PK(l3, h3), od, 0, 0, 0);
#undef AT_PK
}
__device__ __forceinline__ void pv_d0(f32x16* o, int vb, bf16x8 pa0, bf16x8 pa1, bf16x8 pa2, bf16x8 pa3) {
    pv_one<0>(o[0], vb, pa0, pa1, pa2, pa3); pv_one<1>(o[1], vb, pa0, pa1, pa2, pa3); pv_one<2>(o[2], vb, pa0, pa1, pa2, pa3); pv_one<3>(o[3], vb, pa0, pa1, pa2, pa3);
}

template <int DK>
__device__ __forceinline__ void attn_pass(const bf16_t* Qb, int ldq, const bf16_t* Kh, int ldk, const bf16_t* Vh, int ldv, int seq, char* lds, f32x16 (&o)[4]) {
    int tid_o = threadIdx.x; asm volatile("" : "+v"(tid_o)); const int tid = tid_o, wid = tid >> 6, lane = tid & 63, r32 = lane & 31, hi = lane >> 5;
    char* V_lds = lds; char* K_lds = lds + 2 * SHM_V;
    float* wsf = (float*)(lds + 2 * SHM_V + 2 * SHM_K) + wid * 64; float* li_l = wsf; float* al_l = wsf + 32;
    float m_reg = -1e30f, l_reg = 0;
#pragma unroll
    for (int d = 0; d < 4; ++d) o[d] = f32x16{};
    bf16x8 qr[DK / 16];
    const bf16_t* Qw = Qb + (size_t)(wid * QBLK + r32) * ldq + hi * 8;
#pragma unroll
    for (int d0 = 0; d0 < DK / 16; ++d0) qr[d0] = *reinterpret_cast<const bf16x8*>(Qw + d0 * 16);
    const int sr = tid >> 4, sc = (tid & 15) * 8, vst0 = v_st(sr, sc), vst1 = v_st(32 + sr, sc);
    const int kr64 = tid >> 3, kc64 = (tid & 7) * 8;
    const int vb0 = (int)(uintptr_t)V_lds + v_rd_base(lane);
    struct { bf16x8 vs0, vs1, ks0, ks1; } sr_[2];
#define AT_SLOAD(i, k0) do { sr_[i].vs0 = *reinterpret_cast<const bf16x8*>(&Vh[(size_t)((k0) + sr) * ldv + sc]); sr_[i].vs1 = *reinterpret_cast<const bf16x8*>(&Vh[(size_t)((k0) + 32 + sr) * ldv + sc]); \
    if constexpr (DK == 128) { sr_[i].ks0 = *reinterpret_cast<const bf16x8*>(&Kh[(size_t)((k0) + sr) * ldk + sc]); sr_[i].ks1 = *reinterpret_cast<const bf16x8*>(&Kh[(size_t)((k0) + 32 + sr) * ldk + sc]); } \
    else { sr_[i].ks0 = *reinterpret_cast<const bf16x8*>(&Kh[(size_t)((k0) + kr64) * ldk + kc64]); } } while (0)
#define AT_SWRITE(b, i) do { *(bf16x8*)(V_lds + (b) * SHM_V + vst0) = sr_[i].vs0; *(bf16x8*)(V_lds + (b) * SHM_V + vst1) = sr_[i].vs1; \
    if constexpr (DK == 128) { *(bf16x8*)(K_lds + (b) * SHM_K + kswz<128>(sr, sc * 2)) = sr_[i].ks0; *(bf16x8*)(K_lds + (b) * SHM_K + kswz<128>(32 + sr, sc * 2)) = sr_[i].ks1; } \
    else { *(bf16x8*)(K_lds + (b) * SHM_K + kswz<64>(kr64, kc64 * 2)) = sr_[i].ks0; } } while (0)
#define AT_SWAIT() do { if constexpr (DK == 128) asm volatile("s_waitcnt vmcnt(4)" ::: "memory"); else asm volatile("s_waitcnt vmcnt(3)" ::: "memory"); } while (0)
#define AT_RESC(a) do { if (__any((a) < 1.f)) { if (hi == 0) al_l[r32] = (a); asm volatile("s_waitcnt lgkmcnt(0)" ::: "memory"); \
    _Pragma("unroll") for (int d = 0; d < 4; ++d) _Pragma("unroll") for (int r = 0; r < 16; ++r) o[d][r] *= al_l[crow(r, hi)]; } } while (0)
    f32x16 pA0, pA1, pB0, pB1; float mnA, mnB, alA, alB; bf16x8 pa0, pa1, pa2, pa3; const int NT = seq / KVBLK;
    __syncthreads();
    AT_SLOAD(0, 0); asm volatile("s_waitcnt vmcnt(0)" ::: "memory"); AT_SWRITE(0, 0); __syncthreads();
    qkt<DK>(pA0, pA1, K_lds, qr, r32, hi); partialSM<DK>(pA0, pA1, m_reg, mnA, alA);
    AT_SLOAD(1, KVBLK); if (2 < NT) AT_SLOAD(0, 2 * KVBLK);
    AT_SWAIT(); AT_SWRITE(1, 1); __syncthreads();
    for (int j = 1; j + 1 < NT; j += 2) {
        AT_SBAR(); qkt<DK>(pB0, pB1, K_lds + SHM_K, qr, r32, hi);
        finishSM(pA0, pA1, alA, l_reg, pa0, pa1, pa2, pa3); AT_SBAR();
        AT_SLOAD(1, (j + 2) * KVBLK); AT_SBAR();
        pv_d0(o, vb0, pa0, pa1, pa2, pa3); partialSM<DK>(pB0, pB1, m_reg, mnB, alB);
        __syncthreads(); AT_SWAIT(); AT_SWRITE(0, 0);
        AT_RESC(alB); __syncthreads();
        AT_SBAR(); qkt<DK>(pA0, pA1, K_lds, qr, r32, hi);
        finishSM(pB0, pB1, alB, l_reg, pa0, pa1, pa2, pa3); AT_SBAR();
        if (j + 3 < NT) AT_SLOAD(0, (j + 3) * KVBLK); AT_SBAR();
        pv_d0(o, vb0 + SHM_V, pa0, pa1, pa2, pa3); partialSM<DK>(pA0, pA1, m_reg, mnA, alA);
        __syncthreads(); AT_SWAIT(); AT_SWRITE(1, 1);
        AT_RESC(alA); __syncthreads();
    }
    AT_SBAR(); qkt<DK>(pB0, pB1, K_lds + SHM_K, qr, r32, hi);
    finishSM(pA0, pA1, alA, l_reg, pa0, pa1, pa2, pa3); AT_SBAR();
    pv_d0(o, vb0, pa0, pa1, pa2, pa3); partialSM<DK>(pB0, pB1, m_reg, mnB, alB);
    __syncthreads(); AT_RESC(alB);
    finishSM(pB0, pB1, alB, l_reg, pa0, pa1, pa2, pa3); AT_SBAR();
    pv_d0(o, vb0 + SHM_V, pa0, pa1, pa2, pa3);
    if (hi == 0) li_l[r32] = l_reg; asm volatile("s_waitcnt lgkmcnt(0)" ::: "memory");
#pragma unroll
    for (int r = 0; r < 16; ++r) { const float rl = __builtin_amdgcn_rcpf(li_l[crow(r, hi)]);
#pragma unroll
        for (int d = 0; d < 4; ++d) o[d][r] *= rl; }
#undef AT_SLOAD
#undef AT_SWRITE
#undef AT_SWAIT
#undef AT_RESC
}
}

__device__ __forceinline__ void phase3(const Params& p, unsigned char* lds_u, int rep) {
    char* lds = (char*)lds_u;
    int tid_o = threadIdx.x; asm volatile("" : "+v"(tid_o)); const int tid = tid_o;
    int* s_unit = (int*)(lds + 67 * 1024);
    unsigned* ctr = (unsigned*)(p.ws + WS_CTR) + rep;
    const bf16_t* z = (const bf16_t*)(p.ws + WS_Z);
    bf16_t* ob = (bf16_t*)(p.ws + WS_O);
    float* scr = p.out + (size_t)blockIdx.x * 32768; const unsigned voff = (unsigned)tid * 16u;
    for (;;) {
        __syncthreads();
        if (tid == 0) *s_unit = (int)atomicAdd(ctr, 1u);
        __syncthreads();
        const int u = *s_unit;
        if (u >= 768) break;
        f32x16 o[4];
        if (u < 128 || (u >= 256 && u < 512)) {
            int b, h, row0, seq, ldk; const bf16_t *K, *V;
            if (u < 128) { b = u >> 5; h = (u >> 2) & 7; row0 = NCTX + b * 1024 + (u & 3) * 256; seq = LKV; ldk = 1024;
                K = (const bf16_t*)(p.ws + WS_KA) + (size_t)b * LKV * 1024 + h * 128; V = (const bf16_t*)(p.ws + WS_VA) + (size_t)b * LKV * 1024 + h * 128; }
            else { const int v = u - 256; b = v >> 3; h = v & 7; row0 = b * 256; seq = 256; ldk = DIN;
                K = z + (size_t)row0 * DIN + ZKA + h * 128; V = z + (size_t)row0 * DIN + ZVA + h * 128; }
            const bf16_t* Q = z + (size_t)row0 * DIN + ZQA + h * 128;
#pragma unroll 1
            for (int cmap = 0; cmap < 2; ++cmap) {
                at::attn_pass<64>(Q + cmap * 64, DIN, K + cmap * 64, ldk, V, ldk, seq, lds, o);
                if (cmap == 0) {
                    unsigned voff2 = voff; asm volatile("" : "+v"(voff2));
#pragma unroll
                    for (int d = 0; d < 4; ++d)
#pragma unroll
                        for (int q = 0; q < 4; ++q) *(f32x4*)((char*)scr + (d * 4 + q) * 8192 + voff2) = (f32x4){o[d][4 * q], o[d][4 * q + 1], o[d][4 * q + 2], o[d][4 * q + 3]};
                }
            }
            int tid2 = tid; asm volatile("" : "+v"(tid2));
            const int wid = tid2 >> 6, lane = tid2 & 63, r32 = lane & 31, hi = lane >> 5;
            float la = p.lq1[h * 64 + lane] * p.lk1[h * 64 + lane], lb = p.lq2[h * 64 + lane] * p.lk2[h * 64 + lane];
            la = wave_sum(la); lb = wave_sum(lb);
            const float lam = __expf(la) - __expf(lb) + 0.2f;
#pragma unroll
            for (int d = 0; d < 4; ++d)
#pragma unroll
                for (int q = 0; q < 4; ++q) { const f32x4 t = *(const f32x4*)((const char*)scr + (d * 4 + q) * 8192 + (unsigned)(tid2 * 16));
                    o[d][4 * q] = t[0] - lam * o[d][4 * q]; o[d][4 * q + 1] = t[1] - lam * o[d][4 * q + 1]; o[d][4 * q + 2] = t[2] - lam * o[d][4 * q + 2]; o[d][4 * q + 3] = t[3] - lam * o[d][4 * q + 3]; }
            float sg[4];
#pragma unroll
            for (int d = 0; d < 4; ++d) sg[d] = p.subln[d * 32 + r32] * 0.8f;
#pragma unroll
            for (int r = 0; r < 16; ++r) {
                float ss = o[0][r] * o[0][r] + o[1][r] * o[1][r] + o[2][r] * o[2][r] + o[3][r] * o[3][r];
                ss += __shfl_xor(ss, 16); ss += __shfl_xor(ss, 8); ss += __shfl_xor(ss, 4); ss += __shfl_xor(ss, 2); ss += __shfl_xor(ss, 1);
                const float rstd = rsqrtf(ss * (1.0f / 128.0f) + EPS);
                const int row = row0 + wid * 32 + at::crow(r, hi);
#pragma unroll
                for (int d = 0; d < 4; ++d) { const int col = h * 128 + d * 32 + r32;
                    const float g = bf2f(z[(size_t)row * DIN + ZGA + col]);
                    ob[(size_t)row * DM + col] = f2bf(o[d][r] * rstd * sg[d] * g); }
            }
        } else {
            int b, h, row0, seq, ldk; const bf16_t *K, *V;
            if (u < 256) { const int v = u - 128; b = v >> 5; h = (v >> 2) & 7; row0 = NCTX + b * 1024 + (v & 3) * 256; seq = LKV; ldk = 256;
                K = (const bf16_t*)(p.ws + WS_KB) + (size_t)b * LKV * 256 + (h >> 2) * 128; V = (const bf16_t*)(p.ws + WS_VB) + (size_t)b * LKV * 256 + (h >> 2) * 128; }
            else { const int v = u - 512; b = v >> 3; h = v & 7; row0 = b * 256; seq = 256; ldk = DIN;
                K = z + (size_t)row0 * DIN + ZKB + (h >> 2) * 128; V = z + (size_t)row0 * DIN + ZVB + (h >> 2) * 128; }
            const bf16_t* Q = z + (size_t)row0 * DIN + ZQB + h * 128;
            at::attn_pass<128>(Q, DIN, K, ldk, V, ldk, seq, lds, o);
            int tid2 = tid; asm volatile("" : "+v"(tid2));
            const int wid = tid2 >> 6, lane = tid2 & 63, r32 = lane & 31, hi = lane >> 5;
#pragma unroll
            for (int r = 0; r < 16; ++r) { const int row = row0 + wid * 32 + at::crow(r, hi);
#pragma unroll
                for (int d = 0; d < 4; ++d) { const int col = h * 128 + d * 32 + r32;
                    const float g = bf2f(z[(size_t)row * DIN + ZGB + col]);
                    ob[(size_t)row * DM + 1024 + col] = f2bf(o[d][r] * g); } }
        }
    }
}

template <bool DRY> __device__ __forceinline__ void phase5(const Params& p) {
    int tid_o = threadIdx.x; asm volatile("" : "+v"(tid_o)); const int tid = tid_o, wid = tid >> 6, lane = tid & 63, G = gridDim.x, bid = blockIdx.x;
    const float* mod = (const float*)(p.ws + WS_MOD);
    const bf16_t* mm = (const bf16_t*)(p.ws + WS_Z);
    const int rstep = G * 8;
    int row = bid * 8 + wid;
    f32x4 xa[8], na[8]; u32x2 ma[8], nm[8];
#define P5_LOAD(R, V, MV) do { const int r_ = (R); if (r_ < MTOK) { const float* xr_ = r_ < NCTX ? p.x_prompt + (size_t)r_ * DM : p.x_sample + (size_t)(r_ - NCTX) * DM; \
        _Pragma("unroll") for (int i_ = 0; i_ < 8; ++i_) { V[i_] = __builtin_nontemporal_load((const f32x4*)(xr_ + i_ * 256 + lane * 4)); MV[i_] = *(const u32x2*)(mm + (size_t)r_ * DM + i_ * 256 + lane * 4); } } } while (0)
    P5_LOAD(row, xa, ma);
    for (; row < MTOK; row += rstep) {
        P5_LOAD(row + rstep, na, nm);
        const int cn = row < NCTX ? 0 : 1 + ((row - NCTX) >> 10); const float* gt = mod + cn * 6144 + 4096;
        float ss = 0.f;
#pragma unroll
        for (int i = 0; i < 8; ++i) { const f32x4 g = *(const f32x4*)(gt + i * 256 + lane * 4);
            xa[i][0] += g[0] * bf_lo(ma[i].x); xa[i][1] += g[1] * bf_hi(ma[i].x); xa[i][2] += g[2] * bf_lo(ma[i].y); xa[i][3] += g[3] * bf_hi(ma[i].y);
            ss += xa[i][0] * xa[i][0] + xa[i][1] * xa[i][1] + xa[i][2] * xa[i][2] + xa[i][3] * xa[i][3]; }
        ss = wave_sum(ss);
        const float rstd = rsqrtf(ss * (1.0f / DM) + EPS);
        float* yr = p.out + (size_t)row * DM;
#pragma unroll
        for (int i = 0; i < 8; ++i) { const int col = i * 256 + lane * 4; const f32x4 g = *(const f32x4*)(p.g_final + col); __builtin_nontemporal_store((xa[i] * rstd) * g, (f32x4*)(yr + col)); }
#pragma unroll
        for (int i = 0; i < 8; ++i) { xa[i] = na[i]; ma[i] = nm[i]; }
    }
#undef P5_LOAD
}

__global__ void __launch_bounds__(512, 2) mega_fwd(Params p) {
    extern __shared__ __attribute__((aligned(16))) unsigned char lds[];
    cg::grid_group grid = cg::this_grid();
    const int G = gridDim.x, c = blockIdx.x;
#ifndef REP_P0
#define REP_P0 1
#endif
#ifndef REP_P1
#define REP_P1 1
#endif
#ifndef REP_P2
#define REP_P2 1
#endif
#ifndef REP_P3
#define REP_P3 1
#endif
#ifndef REP_P4
#define REP_P4 1
#endif
#ifdef TPROBE
#define TSTAMP(v) const unsigned long long v = wall_clock64()
#else
#define TSTAMP(v)
#endif
    TSTAMP(ts0);
#pragma unroll 1
    for (int rep = 0; rep < REP_P0; ++rep) { phase0(p, lds); grid.sync(); }
    TSTAMP(ts1);
#pragma unroll 1
    for (int rep = 0; rep < REP_P1; ++rep) { phase1(p); grid.sync(); }
    TSTAMP(ts2);
#pragma unroll 1
    for (int rep = 0; rep < REP_P2; ++rep) {
        pg8::Gemm g; g.A = (const bf16_t*)p.out; g.Bt = (const bf16_t*)(p.ws + WS_WIN); g.M = MTOK; g.N = DIN; g.K = DM;
        pg8::StaticOrder S; S.init(g.M, g.N, G, c);
        EpiFused E; E.z = (bf16_t*)(p.ws + WS_Z); E.KA = (bf16_t*)(p.ws + WS_KA); E.VA = (bf16_t*)(p.ws + WS_VA); E.KB = (bf16_t*)(p.ws + WS_KB); E.VB = (bf16_t*)(p.ws + WS_VB);
        E.out = p.out; E.qng = p.qng; E.kng = p.kng; E.P = (PG8_LAS float*)((PG8_LAS unsigned char*)lds + 131072);
        pg8::gemm_phase<EpiFused, pg8::StaticOrder, false>((PG8_LAS unsigned char*)lds, g, S, E, nullptr);
        grid.sync();
    }
    TSTAMP(ts3);
#pragma unroll 1
    for (int rep = 0; rep < REP_P3; ++rep) { phase3(p, lds, rep); grid.sync(); }
    TSTAMP(ts4);
#pragma unroll 1
    for (int rep = 0; rep < REP_P4; ++rep) {
        pg8::Gemm g; g.A = (const bf16_t*)(p.ws + WS_O); g.Bt = (const bf16_t*)(p.ws + WS_WOUT); g.M = MTOK; g.N = DM; g.K = DM;
        pg8::StaticOrder S; S.init(g.M, g.N, G, c);
        EpiZ E; E.O = (bf16_t*)(p.ws + WS_Z); E.ld = DM;
        pg8::gemm_phase<EpiZ, pg8::StaticOrder, false>((PG8_LAS unsigned char*)lds, g, S, E, nullptr);
        grid.sync();
    }
    TSTAMP(ts5);
    phase5<false>(p);
#ifdef TPROBE
    {
        TSTAMP(ts6);
        const unsigned long long tsv[7] = {ts0, ts1, ts2, ts3, ts4, ts5, ts6};
        const unsigned long long dt = tsv[TPROBE + 1] - tsv[TPROBE];
        if (blockIdx.x == 0) { const unsigned long long tend = ts6 + 4ull * dt; while (wall_clock64() < tend) __builtin_amdgcn_s_sleep(32); }
    }
#endif
}

extern "C" void kernel_launch(void* const* d_in, const int* in_sizes, int n_in, void* d_out, int out_size, void* d_ws, size_t ws_size, hipStream_t stream) {
    static int grid_blocks = 0;
    if (grid_blocks == 0) {
        if (n_in != 21 || ws_size < WS_END) { fprintf(stderr, "kernel_launch: unexpected n_in %d / ws %zu\n", n_in, ws_size); grid_blocks = -1; return; }
        int dev = 0, cus = 0, per_cu = 0;
        hipGetDevice(&dev);
        hipDeviceGetAttribute(&cus, hipDeviceAttributeMultiprocessorCount, dev);
        if (hipFuncSetAttribute((const void*)mega_fwd, hipFuncAttributeMaxDynamicSharedMemorySize, LDS_BYTES) != hipSuccess) { fprintf(stderr, "kernel_launch: hipFuncSetAttribute failed\n"); grid_blocks = -1; return; }
        if (hipOccupancyMaxActiveBlocksPerMultiprocessor(&per_cu, (const void*)mega_fwd, 512, LDS_BYTES) != hipSuccess || per_cu < 1) { fprintf(stderr, "kernel_launch: occupancy query failed (%d)\n", per_cu); grid_blocks = -1; return; }
        grid_blocks = cus * per_cu;
        if (grid_blocks > 256) grid_blocks = 256;
    }
    if (grid_blocks < 0) return;
    Params p{};
    p.x_prompt = (const float*)d_in[0]; p.x_sample = (const float*)d_in[1]; p.cdk = (const float*)d_in[2]; p.cdv = (const float*)d_in[3]; p.cgk = (const float*)d_in[4]; p.cgv = (const float*)d_in[5];
    p.c = (const float*)d_in[6]; p.c_ctx = (const float*)d_in[7]; p.w_ada = (const float*)d_in[8]; p.b_ada = (const float*)d_in[9]; p.g_norm = (const float*)d_in[10]; p.w_in = (const float*)d_in[11];
    p.lq1 = (const float*)d_in[12]; p.lk1 = (const float*)d_in[13]; p.lq2 = (const float*)d_in[14]; p.lk2 = (const float*)d_in[15]; p.subln = (const float*)d_in[16]; p.qng = (const float*)d_in[17];
    p.kng = (const float*)d_in[18]; p.w_out = (const float*)d_in[19]; p.g_final = (const float*)d_in[20];
    p.out = (float*)d_out; p.ws = (unsigned char*)d_ws;
    void* args[] = {&p};
    hipError_t e = hipLaunchCooperativeKernel((const void*)mega_fwd, dim3(grid_blocks), dim3(512), args, LDS_BYTES, stream);
    if (e != hipSuccess) fprintf(stderr, "cooperative launch failed: %s (grid %d)\n", hipGetErrorString(e), grid_blocks);
}
```
